# Optimizing an MI355X kernel written in HIP

```python
import math
import jax
import jax.numpy as jnp
from jax import lax
import numpy as np

D_MODEL = 1024
BATCH = 16
SEQ = 2048
DEPTH = 4

GRID_W = 64
CTX_LEN = 256

DA_HEADS = 4
DA_HEAD_DIM = 48
DA_V_DIM = 2 * DA_HEAD_DIM
DA_WIDTH = DA_HEADS * DA_V_DIM
DA_IN = 3 * DA_HEADS * 2 * DA_HEAD_DIM

HY_CH = 256
HY_ORDER = 2
HY_SHORT = 3
HY_EMB = 33
HY_HIDDEN = 64
HY_DECAY_TARGET = 1e-2
HY_DECAY_SHORT_PCT = 0.3
HY_DECAY_LONG_PCT = 1.5
HY_DECAY_SHIFT = 0.05
HY_IN = (HY_ORDER + 1) * HY_CH

MLA_HEADS = 6
MLA_Q_RANK = 256
MLA_KV_RANK = 128
MLA_NOPE = 64
MLA_ROPE = 32
MLA_V = 64
MLA_WIDTH = MLA_HEADS * MLA_V
MLA_IN = MLA_Q_RANK + MLA_KV_RANK + MLA_ROPE

IN_WIDTH = DA_IN + HY_IN + MLA_IN
MIX_WIDTH = DA_WIDTH + HY_CH + MLA_WIDTH

FFN_DIM = 2816
N_EXPERTS = 8
TOP_K = 2
EXPERT_DIM = 2816
MOE_BLOCK = 256

ROPE_BASE = 10000.0
Q_BLOCK = 128
LN_EPS = 1e-5
RMS_EPS = 1e-6
DEEPNORM_ALPHA = (2 * DEPTH) ** 0.25
DEEPNORM_BETA = (8 * DEPTH) ** -0.25

kernel_name = 'hybrid_diffattn_hyena_mla_moe_trunk'


def _layer_norm(x, g, b):
    xf = x.astype(jnp.float32)
    mu = jnp.mean(xf, axis=-1, keepdims=True)
    var = jnp.mean(jnp.square(xf - mu), axis=-1, keepdims=True)
    return ((xf - mu) * lax.rsqrt(var + LN_EPS) * g + b).astype(x.dtype)


def _rms_norm(x, g):
    xf = x.astype(jnp.float32)
    return (xf * lax.rsqrt(jnp.mean(xf * xf, axis=-1, keepdims=True) + RMS_EPS) * g).astype(x.dtype)


def _modulate(h, shift, scale):
    return h * (1.0 + scale) + shift


def _axial_rope_tables(n_tokens, rot_dim):
    rows = n_tokens // GRID_W
    row = jnp.broadcast_to(jnp.arange(rows)[:, None], (rows, GRID_W)).reshape(-1).astype(jnp.float32)
    col = jnp.broadcast_to(jnp.arange(GRID_W)[None, :], (rows, GRID_W)).reshape(-1).astype(jnp.float32)
    axis_dim = rot_dim // 2
    inv_freq = ROPE_BASE ** (-jnp.arange(0, axis_dim, 2, dtype=jnp.float32) / axis_dim)

    def table(pos):
        ang = pos[:, None] * inv_freq[None, :]
        ang = jnp.concatenate([ang, ang], axis=-1)
        return jnp.cos(ang), jnp.sin(ang)

    cos_r, sin_r = table(row)
    cos_c, sin_c = table(col)
    return cos_r, sin_r, cos_c, sin_c


def _rotate_half(x):
    x1, x2 = jnp.split(x, 2, axis=-1)
    return jnp.concatenate([-x2, x1], axis=-1)


def _apply_axial_rope(x, tables):
    cos_r, sin_r, cos_c, sin_c = tables
    xr, xc = jnp.split(x.astype(jnp.float32), 2, axis=-1)
    out = jnp.concatenate([xr * cos_r + _rotate_half(xr) * sin_r,
                           xc * cos_c + _rotate_half(xc) * sin_c], axis=-1)
    return out.astype(x.dtype)


def _attn_probs(q, k, scale):
    s = jnp.einsum('bhqd,bhkd->bhqk', q, k).astype(jnp.float32) * scale
    return jax.nn.softmax(s, axis=-1)


def _softmax_attend(q, k, v, scale):
    p = _attn_probs(q, k, scale)
    return jnp.einsum('bhqk,bhkd->bhqd', p.astype(v.dtype), v)


def _sweep_query_blocks(fn, qs):
    b, h, n, _ = qs[0].shape
    nb = n // Q_BLOCK
    blocks = tuple(q.reshape(b, h, nb, Q_BLOCK, q.shape[-1]).transpose(2, 0, 1, 3, 4) for q in qs)
    out = lax.map(lambda qb: fn(*qb), blocks)
    return out.transpose(1, 2, 0, 3, 4).reshape(b, h, n, out.shape[-1])


def _diff_attention(p_ctx, p_lat, rope, lam_q1, lam_k1, lam_q2, lam_k2, subln_g, lambda_init, need_ctx):
    def split_heads(p):
        b, n, _ = p.shape
        q, k, v = jnp.split(p, 3, axis=-1)
        q = q.reshape(b, n, DA_HEADS, 2, DA_HEAD_DIM).transpose(3, 0, 2, 1, 4)
        k = k.reshape(b, n, DA_HEADS, 2, DA_HEAD_DIM).transpose(3, 0, 2, 1, 4)
        v = v.reshape(b, n, DA_HEADS, DA_V_DIM).transpose(0, 2, 1, 3)
        return q, k, v

    q_c, k_c, v_c = split_heads(p_ctx)
    q_l, k_l, v_l = split_heads(p_lat)
    q_l = _apply_axial_rope(q_l, rope)
    k_l = _apply_axial_rope(k_l, rope)
    f32 = jnp.float32
    lam = (jnp.exp(jnp.sum(lam_q1.astype(f32) * lam_k1.astype(f32)))
           - jnp.exp(jnp.sum(lam_q2.astype(f32) * lam_k2.astype(f32))) + lambda_init)
    scale = DA_HEAD_DIM ** -0.5

    def attend(q1, q2, k1, k2, v):
        a = _attn_probs(q1, k1, scale) - lam * _attn_probs(q2, k2, scale)
        return jnp.einsum('bhqk,bhkd->bhqd', a.astype(v.dtype), v)

    def merge(o):
        b, h, n, dv = o.shape
        o = _rms_norm(o, subln_g) * (1.0 - lambda_init)
        return o.transpose(0, 2, 1, 3).reshape(b, n, h * dv)

    k_all = jnp.concatenate([k_c, k_l], axis=3)
    v_all = jnp.concatenate([v_c, v_l], axis=2)
    o_lat = _sweep_query_blocks(lambda q1, q2: attend(q1, q2, k_all[0], k_all[1], v_all), (q_l[0], q_l[1]))
    o_ctx = merge(attend(q_c[0], q_c[1], k_c[0], k_c[1], v_c)) if need_ctx else None
    return o_ctx, merge(o_lat)


def _hyena_filter_spectrum(n, fw1, fb1, fw2, fb2, fw3, fb3, fw4, freq):
    f32 = jnp.float32
    t = jnp.linspace(0.0, 1.0, n, dtype=f32)[:, None]
    bands = (HY_EMB - 1) // 2
    w = 2.0 * math.pi * jnp.arange(n, dtype=f32)[:, None] / n
    f = jnp.linspace(1e-4, bands - 1, bands, dtype=f32)[None, :]
    z = jnp.concatenate([t, jnp.cos(f * w), -jnp.sin(f * w)], axis=-1)
    fr = freq.astype(f32)
    hdn = jnp.sin(fr * (z @ fw1.astype(f32) + fb1.astype(f32)))
    hdn = jnp.sin(fr * (hdn @ fw2.astype(f32) + fb2.astype(f32)))
    hdn = jnp.sin(fr * (hdn @ fw3.astype(f32) + fb3.astype(f32)))
    filt = (hdn @ fw4.astype(f32)).reshape(n, 2, HY_ORDER, HY_CH)
    max_decay = math.log(HY_DECAY_TARGET) / HY_DECAY_SHORT_PCT
    min_decay = math.log(HY_DECAY_TARGET) / HY_DECAY_LONG_PCT
    deltas = jnp.linspace(min_decay, max_decay, HY_CH, dtype=f32)
    window = jnp.exp(-t * jnp.abs(deltas)[None, :]) + HY_DECAY_SHIFT
    filt = filt * window[:, None, None, :]
    fwd, bwd = filt[:, 0], filt[:, 1]
    circ = jnp.concatenate([fwd, jnp.zeros((1, HY_ORDER, HY_CH), f32), bwd[:0:-1]], axis=0)
    return jnp.fft.rfft(circ, axis=0)


def _long_conv(z, spec, bias):
    n = z.shape[1]
    zf = z.astype(jnp.float32)
    y = jnp.fft.irfft(jnp.fft.rfft(zf, n=2 * n, axis=1) * spec[None], n=2 * n, axis=1)[:, :n]
    return (y + zf * bias.astype(jnp.float32)).astype(z.dtype)


def _hyena(p, conv_w, conv_b, fw1, fb1, fw2, fb2, fw3, fb3, fw4, freq, bias):
    n = p.shape[1]
    u = lax.conv_general_dilated(p, conv_w[:, None, :], window_strides=(1,),
                                 padding=((HY_SHORT // 2, HY_SHORT // 2),),
                                 dimension_numbers=('NWC', 'WIO', 'NWC'),
                                 feature_group_count=p.shape[-1]) + conv_b
    parts = jnp.split(u, HY_ORDER + 1, axis=-1)
    gates, z = parts[:-1], parts[-1]
    spec = _hyena_filter_spectrum(n, fw1, fb1, fw2, fb2, fw3, fb3, fw4, freq)
    for i in range(HY_ORDER):
        z = gates[i] * _long_conv(z, spec[:, i], bias[i])
    return z


def _mla(p_ctx, p_lat, rope, q_norm_g, w_uq, kv_norm_g, w_ukv, need_ctx):
    def project(p, rotate):
        b, n, _ = p.shape
        c_q, c_kv, k_rope = jnp.split(p, [MLA_Q_RANK, MLA_Q_RANK + MLA_KV_RANK], axis=-1)
        q = (_rms_norm(c_q, q_norm_g) @ w_uq).reshape(b, n, MLA_HEADS, MLA_NOPE + MLA_ROPE).transpose(0, 2, 1, 3)
        kv = (_rms_norm(c_kv, kv_norm_g) @ w_ukv).reshape(b, n, MLA_HEADS, MLA_NOPE + MLA_V).transpose(0, 2, 1, 3)
        q_nope, q_rope = jnp.split(q, [MLA_NOPE], axis=-1)
        k_nope, v = jnp.split(kv, [MLA_NOPE], axis=-1)
        k_rope = k_rope[:, None]
        if rotate:
            q_rope = _apply_axial_rope(q_rope, rope)
            k_rope = _apply_axial_rope(k_rope, rope)
        q = jnp.concatenate([q_nope, q_rope], axis=-1)
        k = jnp.concatenate([k_nope, jnp.broadcast_to(k_rope, (b, MLA_HEADS, n, MLA_ROPE))], axis=-1)
        return q, k, v

    def merge(o):
        b, h, n, dv = o.shape
        return o.transpose(0, 2, 1, 3).reshape(b, n, h * dv)

    scale = (MLA_NOPE + MLA_ROPE) ** -0.5
    q_c, k_c, v_c = project(p_ctx, False)
    q_l, k_l, v_l = project(p_lat, True)
    k_all = jnp.concatenate([k_c, k_l], axis=2)
    v_all = jnp.concatenate([v_c, v_l], axis=2)
    o_lat = _sweep_query_blocks(lambda q: _softmax_attend(q, k_all, v_all, scale), (q_l,))
    o_ctx = merge(_softmax_attend(q_c, k_c, v_c, scale)) if need_ctx else None
    return o_ctx, merge(o_lat)


def _swiglu(h, w_gate, w_up, w_down):
    return (jax.nn.silu(h @ w_gate) * (h @ w_up)) @ w_down


def _moe_swiglu(h, router_w, w_gate, w_up, w_down):
    b, n, d = h.shape
    tokens = h.reshape(b * n, d)
    n_tok = b * n
    n_assign = n_tok * TOP_K
    logits = (tokens @ router_w).astype(jnp.float32)
    top_logits, top_idx = lax.top_k(logits, TOP_K)
    gates = jax.nn.softmax(top_logits, axis=-1).reshape(n_assign)
    expert_of = top_idx.reshape(n_assign)
    order = jnp.argsort(expert_of)
    sorted_expert = expert_of[order]
    token_of = order // TOP_K
    counts = jnp.bincount(expert_of, length=N_EXPERTS)
    padded = (counts + MOE_BLOCK - 1) // MOE_BLOCK * MOE_BLOCK
    padded_end = jnp.cumsum(padded)
    padded_start = padded_end - padded
    group_start = jnp.cumsum(counts) - counts
    dest = padded_start[sorted_expert] + jnp.arange(n_assign) - group_start[sorted_expert]
    n_blocks = -(-(n_assign + N_EXPERTS * (MOE_BLOCK - 1)) // MOE_BLOCK)
    rows = jnp.zeros((n_blocks * MOE_BLOCK, d), h.dtype).at[dest].set(tokens[token_of])
    block_expert = jnp.minimum(
        jnp.searchsorted(padded_end, jnp.arange(n_blocks) * MOE_BLOCK, side='right'), N_EXPERTS - 1)

    def expert_block(args):
        xb, e = args
        return _swiglu(xb, w_gate[e], w_up[e], w_down[e])

    out = lax.map(expert_block, (rows.reshape(n_blocks, MOE_BLOCK, d), block_expert)).reshape(-1, d)
    contrib = out[dest] * gates[order][:, None].astype(h.dtype)
    y = jnp.zeros((n_tok, d), h.dtype).at[token_of].add(contrib)
    return y.reshape(b, n, d)


def setup_inputs(seed: int = 0) -> dict:
    key = jax.random.key(seed)
    keys = iter(jax.random.split(key, 64))
    f32 = jnp.float32
    D = D_MODEL
    n_dense = (DEPTH + 1) // 2
    n_moe = DEPTH // 2

    def normal(shape, scale):
        return jax.random.normal(next(keys), shape, f32) * scale

    def gain(shape):
        return 1.0 + normal(shape, 0.05)

    return {
        'x': normal((BATCH, SEQ, D), 1.0),
        'c': normal((BATCH, D), 1.0),
        'ctx': normal((BATCH, CTX_LEN, D), 1.0),
        'c_ctx': normal((D,), 1.0),
        'ada_w': normal((DEPTH, D, 6 * D), 0.5 * D ** -0.5),
        'ada_b': normal((DEPTH, 6 * D), 0.02),
        'w_in': normal((DEPTH, D, IN_WIDTH), D ** -0.5),
        'da_lambda_q1': normal((DEPTH, DA_HEAD_DIM), 0.1),
        'da_lambda_k1': normal((DEPTH, DA_HEAD_DIM), 0.1),
        'da_lambda_q2': normal((DEPTH, DA_HEAD_DIM), 0.1),
        'da_lambda_k2': normal((DEPTH, DA_HEAD_DIM), 0.1),
        'da_subln_g': gain((DEPTH, DA_V_DIM)),
        'hy_conv_w': normal((DEPTH, HY_SHORT, HY_IN), HY_SHORT ** -0.5),
        'hy_conv_b': normal((DEPTH, HY_IN), 0.02),
        'hy_fw1': normal((DEPTH, HY_EMB, HY_HIDDEN), HY_EMB ** -0.5),
        'hy_fb1': normal((DEPTH, HY_HIDDEN), 0.02),
        'hy_fw2': normal((DEPTH, HY_HIDDEN, HY_HIDDEN), HY_HIDDEN ** -0.5),
        'hy_fb2': normal((DEPTH, HY_HIDDEN), 0.02),
        'hy_fw3': normal((DEPTH, HY_HIDDEN, HY_HIDDEN), HY_HIDDEN ** -0.5),
        'hy_fb3': normal((DEPTH, HY_HIDDEN), 0.02),
        'hy_fw4': normal((DEPTH, HY_HIDDEN, 2 * HY_ORDER * HY_CH), 0.05 * HY_HIDDEN ** -0.5),
        'hy_freq': gain((DEPTH, HY_HIDDEN)),
        'hy_bias': normal((DEPTH, HY_ORDER, HY_CH), 0.1),
        'mla_q_norm_g': gain((DEPTH, MLA_Q_RANK)),
        'mla_w_uq': normal((DEPTH, MLA_Q_RANK, MLA_HEADS * (MLA_NOPE + MLA_ROPE)), MLA_Q_RANK ** -0.5),
        'mla_kv_norm_g': gain((DEPTH, MLA_KV_RANK)),
        'mla_w_ukv': normal((DEPTH, MLA_KV_RANK, MLA_HEADS * (MLA_NOPE + MLA_V)), MLA_KV_RANK ** -0.5),
        'w_out': normal((DEPTH, MIX_WIDTH, D), DEEPNORM_BETA * MIX_WIDTH ** -0.5),
        'ln1_g': gain((DEPTH, D)),
        'ln1_b': normal((DEPTH, D), 0.02),
        'ln2_g': gain((DEPTH, D)),
        'ln2_b': normal((DEPTH, D), 0.02),
        'ffn_w_gate': normal((n_dense, D, FFN_DIM), D ** -0.5),
        'ffn_w_up': normal((n_dense, D, FFN_DIM), D ** -0.5),
        'ffn_w_down': normal((n_dense, FFN_DIM, D), DEEPNORM_BETA * FFN_DIM ** -0.5),
        'moe_router': normal((n_moe, D, N_EXPERTS), D ** -0.5),
        'moe_w_gate': normal((n_moe, N_EXPERTS, D, EXPERT_DIM), D ** -0.5),
        'moe_w_up': normal((n_moe, N_EXPERTS, D, EXPERT_DIM), D ** -0.5),
        'moe_w_down': normal((n_moe, N_EXPERTS, EXPERT_DIM, D), DEEPNORM_BETA * EXPERT_DIM ** -0.5),
    }


def reference(x, c, ctx, c_ctx, ada_w, ada_b, w_in, da_lambda_q1, da_lambda_k1, da_lambda_q2,
              da_lambda_k2, da_subln_g, hy_conv_w, hy_conv_b, hy_fw1, hy_fb1, hy_fw2, hy_fb2, hy_fw3,
              hy_fb3, hy_fw4, hy_freq, hy_bias, mla_q_norm_g, mla_w_uq, mla_kv_norm_g, mla_w_ukv, w_out,
              ln1_g, ln1_b, ln2_g, ln2_b, ffn_w_gate, ffn_w_up, ffn_w_down, moe_router, moe_w_gate,
              moe_w_up, moe_w_down):
    n_lat = x.shape[1]
    n_ctx = ctx.shape[1]
    rope_da = _axial_rope_tables(n_lat, DA_HEAD_DIM)
    rope_mla = _axial_rope_tables(n_lat, MLA_ROPE)
    c_act = jax.nn.silu(c)
    c_ctx_act = jax.nn.silu(c_ctx)
    for layer in range(DEPTH):
        need_ctx = layer < DEPTH - 1
        mod_lat = jnp.split((c_act @ ada_w[layer] + ada_b[layer])[:, None, :], 6, axis=-1)
        mod_ctx = jnp.split(c_ctx_act @ ada_w[layer] + ada_b[layer], 6, axis=-1)

        h = jnp.concatenate([_modulate(ctx, mod_ctx[0], mod_ctx[1]),
                             _modulate(x, mod_lat[0], mod_lat[1])], axis=1)
        proj = h @ w_in[layer]
        da_c, hy_c, mla_c = jnp.split(proj[:, :n_ctx], [DA_IN, DA_IN + HY_IN], axis=-1)
        da_l, hy_l, mla_l = jnp.split(proj[:, n_ctx:], [DA_IN, DA_IN + HY_IN], axis=-1)
        lambda_init = 0.8 - 0.6 * math.exp(-0.3 * layer)
        da_out_c, da_out_l = _diff_attention(da_c, da_l, rope_da, da_lambda_q1[layer], da_lambda_k1[layer],
                                             da_lambda_q2[layer], da_lambda_k2[layer], da_subln_g[layer],
                                             lambda_init, need_ctx)
        hy_params = (hy_conv_w[layer], hy_conv_b[layer], hy_fw1[layer], hy_fb1[layer], hy_fw2[layer],
                     hy_fb2[layer], hy_fw3[layer], hy_fb3[layer], hy_fw4[layer], hy_freq[layer], hy_bias[layer])
        hy_out_l = _hyena(hy_l, *hy_params)
        mla_out_c, mla_out_l = _mla(mla_c, mla_l, rope_mla, mla_q_norm_g[layer], mla_w_uq[layer],
                                    mla_kv_norm_g[layer], mla_w_ukv[layer], need_ctx)
        o_lat = jnp.concatenate([da_out_l, hy_out_l, mla_out_l], axis=-1) @ w_out[layer]
        x = _layer_norm(DEEPNORM_ALPHA * x + mod_lat[2] * o_lat, ln1_g[layer], ln1_b[layer])
        if need_ctx:
            hy_out_c = _hyena(hy_c, *hy_params)
            o_ctx = jnp.concatenate([da_out_c, hy_out_c, mla_out_c], axis=-1) @ w_out[layer]
            ctx = _layer_norm(DEEPNORM_ALPHA * ctx + mod_ctx[2] * o_ctx, ln1_g[layer], ln1_b[layer])
            h2 = jnp.concatenate([_modulate(ctx, mod_ctx[3], mod_ctx[4]),
                                  _modulate(x, mod_lat[3], mod_lat[4])], axis=1)
        else:
            h2 = _modulate(x, mod_lat[3], mod_lat[4])

        idx = layer // 2
        if layer % 2 == 0:
            f = _swiglu(h2, ffn_w_gate[idx], ffn_w_up[idx], ffn_w_down[idx])
        else:
            f = _moe_swiglu(h2, moe_router[idx], moe_w_gate[idx], moe_w_up[idx], moe_w_down[idx])
        x = _layer_norm(DEEPNORM_ALPHA * x + mod_lat[5] * f[:, f.shape[1] - n_lat:], ln2_g[layer], ln2_b[layer])
        if need_ctx:
            ctx = _layer_norm(DEEPNORM_ALPHA * ctx + mod_ctx[5] * f[:, :n_ctx], ln2_g[layer], ln2_b[layer])
    return x
```

```cpp
#include <hip/hip_runtime.h>
#include <cstdio>
#include <cstdint>

#ifndef MK_SINGLE
#define MK_SINGLE 1
#endif

#define LAS __attribute__((address_space(3)))
typedef unsigned short bf16_t;
typedef short bf16x8 __attribute__((ext_vector_type(8)));
typedef short s16x4 __attribute__((ext_vector_type(4)));
typedef float f32x4 __attribute__((ext_vector_type(4)));
typedef float f32x2 __attribute__((ext_vector_type(2)));
typedef float f32x16 __attribute__((ext_vector_type(16)));
typedef unsigned u32x4 __attribute__((ext_vector_type(4)));
typedef unsigned u32x2 __attribute__((ext_vector_type(2)));

constexpr int D = 1024, NB = 16, SEQ = 2048, CTXL = 256, TPB = SEQ + CTXL, MR = NB * TPB, DEPTH = 4;
constexpr int PLD = 2336, NINP = 2560;
constexpr int C_DAQ = 0, C_DAK = 384, C_DAV = 768, C_HY = 1152, C_CQ = 1920, C_CKV = 2176, C_KR = 2304;
constexpr int FF = 2816, NE = 8;
constexpr int MQLD = 576, MKVLD = 768;
constexpr int MOE_MAXT = 296;
constexpr int MOE_CH = 296;
constexpr int MOE_NCH = 1;
constexpr float LN_EPS = 1e-5f, RMS_EPS = 1e-6f;
constexpr float HSCL = 4.0f;
constexpr float ALPHA = 1.6817928305074290f;
constexpr float LOG2E = 1.4426950408889634f;
constexpr float SC_DA = 0.14433756729740643f * LOG2E;
constexpr float SC_ML = 0.10206207261596575f * LOG2E;
constexpr int LDS_BYTES = 147456;
constexpr int LDS_MISC = LDS_BYTES - 1024;

constexpr size_t al(size_t x) { return (x + 255) & ~size_t(255); }
constexpr size_t CTL_BYTES = 65536;
constexpr size_t WS_CTL = 0;
constexpr size_t WS_MOD = WS_CTL + CTL_BYTES;
constexpr size_t WS_ROPE_DA = al(WS_MOD + 4ull * 17 * 6144 * 4);
constexpr size_t WS_ROPE_ML = al(WS_ROPE_DA + 64 * 12 * 8);
constexpr size_t WS_LAM = al(WS_ROPE_ML + 64 * 8 * 8);
constexpr size_t WS_HF = al(WS_LAM + 256);
constexpr size_t WS_HFC = al(WS_HF + 4ull * 2 * 256 * 4096 * 2);
constexpr size_t WS_WIN = al(WS_HFC + 4ull * 2 * 256 * 512 * 2);
constexpr size_t WS_WINS = al(WS_WIN + 4ull * NINP * 1024);
constexpr size_t WS_WOUT = al(WS_WINS + 4ull * NINP * 4);
constexpr size_t WS_WUQ = al(WS_WOUT + 4ull * 1024 * 1024 * 2);
constexpr size_t WS_WUKV = al(WS_WUQ + 4ull * 768 * 256 * 2);
constexpr size_t WS_WGU = al(WS_WUKV + 4ull * 768 * 256 * 2);
constexpr size_t WS_WGUS = al(WS_WGU + 2ull * 5632 * 1024);
constexpr size_t WS_WD = al(WS_WGUS + 2ull * 5632 * 4);
constexpr size_t WS_WDS = al(WS_WD + 2ull * 1024 * 2816);
constexpr size_t WS_MGU = al(WS_WDS + 2ull * 1024 * 4);
constexpr size_t WS_MGUS = al(WS_MGU + 8ull * 5632 * 1024);
constexpr size_t WS_MD = al(WS_MGUS + 8ull * 5632 * 4);
constexpr size_t WS_MDS = al(WS_MD + 8ull * 1024 * 2816);
constexpr size_t WS_X = al(WS_MDS + 8ull * 1024 * 4);
constexpr size_t WS_YH = WS_X, WS_XH = WS_X + (size_t)MR * 1024 * 2;
constexpr size_t WS_HMOD = al(WS_X + (size_t)MR * 1024 * 4);
constexpr size_t WS_HSC = al(WS_HMOD + (size_t)MR * 1024);
constexpr size_t WS_MASG = al(WS_HSC + (size_t)MR * 4);
constexpr size_t WS_MGATE = al(WS_MASG + (size_t)MR * 16);
constexpr size_t WS_R = al(WS_MGATE + (size_t)MR * 8);
constexpr size_t WS_PROJ = WS_R;
constexpr size_t WS_MIX = al(WS_PROJ + (size_t)MR * PLD * 2);
constexpr size_t WS_UT = al(WS_MIX + (size_t)MR * 1024 * 2);
constexpr size_t WS_UTC = al(WS_UT + 768ull * 16 * 2048 * 2);
constexpr size_t WS_HYT = al(WS_UTC + 768ull * 16 * 256 * 2);
constexpr size_t WS_HYTC = al(WS_HYT + 256ull * 16 * 2048 * 2);
constexpr size_t WS_CQN = al(WS_HYTC + 256ull * 16 * 256 * 2);
constexpr size_t WS_CKVN = al(WS_CQN + (size_t)MR * 256 * 2);
constexpr size_t WS_SS = WS_CQN;
constexpr size_t WS_MQ = al(WS_CKVN + (size_t)MR * 256 * 2);
constexpr size_t WS_MKV = al(WS_MQ + (size_t)MR * MQLD * 2);
constexpr size_t WS_END = al(WS_MKV + (size_t)MR * MKVLD * 2);
constexpr size_t WS_HID = WS_R;
constexpr size_t WS_ROWS = WS_R;
constexpr size_t WS_HIDC = al(WS_ROWS + (size_t)MOE_MAXT * 256 * 1024 * 2);
constexpr size_t WS_ROWS8 = al(WS_HIDC + (size_t)MOE_CH * 256 * FF);
constexpr size_t WS_RSC = al(WS_ROWS8 + (size_t)MOE_MAXT * 256 * 1024);
static_assert(WS_HID + (size_t)MR * FF * 2 <= WS_UT, "dense hidden must fit over proj+mix");
static_assert(WS_RSC + (size_t)MOE_MAXT * 256 * 4 <= WS_END, "moe buffers must fit in region");
static_assert(WS_END <= 934000000ull, "workspace budget");

constexpr int CW_BAR = 0;
constexpr int CW_QUEUE = 4096;
constexpr int CW_MCNT = 4096 + 256 * 4;
constexpr int CW_MTILE = 8192;
constexpr int CW_XQ = 12288;
constexpr int CW_KMAX = 10240;

struct Args { const float* in[39]; float* out; unsigned char* ws; int ph_lo, ph_hi, use_bar, pad; };

typedef __bf16 bf16v2_t __attribute__((ext_vector_type(2)));
__device__ __forceinline__ unsigned cvt_pk_bf16(float lo, float hi) { return __builtin_bit_cast(unsigned, __builtin_convertvector((f32x2){lo, hi}, bf16v2_t)); }
typedef _Float16 f16v2_t __attribute__((ext_vector_type(2)));
__device__ __forceinline__ unsigned cvt_pk_f16(float lo, float hi) { lo = __builtin_amdgcn_fmed3f(lo, -65504.0f, 65504.0f); hi = __builtin_amdgcn_fmed3f(hi, -65504.0f, 65504.0f);
    return __builtin_bit_cast(unsigned, __builtin_convertvector((f32x2){lo, hi}, f16v2_t)); }
__device__ __forceinline__ f32x2 unpk_f16(unsigned w) { return __builtin_convertvector(__builtin_bit_cast(f16v2_t, w), f32x2); }
__device__ __forceinline__ float bf2f(bf16_t v) { return __uint_as_float(((unsigned)v) << 16); }
__device__ __forceinline__ float bflo(unsigned v) { return __uint_as_float(v << 16); }
__device__ __forceinline__ float bfhi(unsigned v) { return __uint_as_float(v & 0xffff0000u); }
__device__ __forceinline__ bf16_t f2bf(float f) { return (bf16_t)(cvt_pk_bf16(f, 0.f) & 0xffffu); }
__device__ __forceinline__ float shfl_x(float v, int lane, int mask) { return __int_as_float(__builtin_amdgcn_ds_bpermute((lane ^ mask) << 2, __float_as_int(v))); }
template <int CTRL, int ROWMASK> __device__ __forceinline__ float dpp_f(float v) { return __int_as_float(__builtin_amdgcn_update_dpp(0, __float_as_int(v), CTRL, ROWMASK, 0xf, false)); }
__device__ __forceinline__ float wave_sum(float v, int) {
    v += dpp_f<0xb1, 0xf>(v); v += dpp_f<0x4e, 0xf>(v); v += dpp_f<0x124, 0xf>(v); v += dpp_f<0x128, 0xf>(v);
    v += dpp_f<0x142, 0xa>(v); v += dpp_f<0x143, 0xc>(v);
    return __int_as_float(__builtin_amdgcn_readlane(__float_as_int(v), 63));
}
__device__ __forceinline__ float wave_max_nonneg(float v) {
    v = fmaxf(v, dpp_f<0xb1, 0xf>(v)); v = fmaxf(v, dpp_f<0x4e, 0xf>(v)); v = fmaxf(v, dpp_f<0x124, 0xf>(v)); v = fmaxf(v, dpp_f<0x128, 0xf>(v));
    v = fmaxf(v, dpp_f<0x142, 0xa>(v)); v = fmaxf(v, dpp_f<0x143, 0xc>(v));
    return __int_as_float(__builtin_amdgcn_readlane(__float_as_int(v), 63));
}
__device__ __forceinline__ float fast_exp2(float x) { return __builtin_amdgcn_exp2f(x); }
__device__ __forceinline__ float add1(float a, float b) { float r; asm("v_add_f32 %0, %1, %2" : "=v"(r) : "v"(a), "v"(b)); return r; }
__device__ __forceinline__ float fast_exp(float x) { return __builtin_amdgcn_exp2f(x * LOG2E); }
__device__ __forceinline__ float fast_sin(float x) { float r = x * 0.15915494309189535f; r -= rintf(r); return __builtin_amdgcn_sinf(r); }
__device__ __forceinline__ float fast_cos(float x) { float r = x * 0.15915494309189535f; r -= rintf(r); return __builtin_amdgcn_cosf(r); }
__device__ __forceinline__ float silu(float x) { return x / (1.0f + fast_exp(-x)); }
__device__ __forceinline__ unsigned pack_i8x4(f32x4 q) {
    const int a = (int)q[0], b = (int)q[1], c = (int)q[2], d = (int)q[3];
    return (unsigned)(a & 255) | ((unsigned)(b & 255) << 8) | ((unsigned)(c & 255) << 16) | ((unsigned)d << 24);
}

#define XB_TMO      128
#define XB_XCNT(j)  (256  + 64 * (j))
#define XB_XSUB(j)  (1280 + 64 * (j))
#define XB_XGEN(j)  (2304 + 64 * (j))
#define XB_TOP      3328
#define XB_TOPGEN   3392
#define XCD_BAR_WORDS 3456
#define XB_SPIN_CAP (1u << 22)
__device__ __forceinline__ unsigned xb_ld(unsigned* p)              { return __hip_atomic_load(p, __ATOMIC_RELAXED, __HIP_MEMORY_SCOPE_AGENT); }
__device__ __forceinline__ unsigned xb_add(unsigned* p, unsigned v) { return __hip_atomic_fetch_add(p, v, __ATOMIC_RELAXED, __HIP_MEMORY_SCOPE_AGENT); }
__device__ __forceinline__ unsigned xb_xcc_id() { return (unsigned)__builtin_amdgcn_s_getreg((3 << 11) | 20) & 0xFu; }
#define XB_SPIN(cond, bar) do { unsigned _sp = 0; while (cond) { __builtin_amdgcn_s_sleep(1); \
    if ((++_sp & 255u) == 0u) { if (xb_ld(&(bar)[XB_TMO])) break; if (_sp > XB_SPIN_CAP) { atomicAdd(&(bar)[XB_TMO], 1u); break; } } } } while (0)
struct XcdBarrier { unsigned* bar; unsigned x; volatile LAS unsigned* st; };
__device__ __forceinline__ XcdBarrier xcd_barrier_post(unsigned* bar, volatile LAS unsigned* st) {
    XcdBarrier b; b.bar = bar; b.x = xb_xcc_id(); b.st = st;
    if (threadIdx.x == 0) (void)xb_add(&bar[XB_XCNT(b.x)], 1u);
    return b;
}
__device__ __forceinline__ void xcd_barrier_complete(unsigned* bar, unsigned x, unsigned& nloc, unsigned& nx) {
    const unsigned G = gridDim.x * gridDim.y * gridDim.z;
    unsigned sum, cnt, mine, sp = 0u;
    for (;;) {
        sum = 0u; cnt = 0u; mine = 0u;
#pragma unroll
        for (unsigned j = 0; j < 16; ++j) { const unsigned c = xb_ld(&bar[XB_XCNT(j)]); sum += c; cnt += (c > 0u) ? 1u : 0u; mine = (j == x) ? c : mine; }
        if (sum == G) break;
        __builtin_amdgcn_s_sleep(1);
        if ((++sp & 255u) == 0u) { if (xb_ld(&bar[XB_TMO])) break; if (sp > XB_SPIN_CAP) { atomicAdd(&bar[XB_TMO], 1u); break; } }
    }
    nloc = mine > 0u ? mine : 1u; nx = cnt > 0u ? cnt : 1u;
}
__device__ __forceinline__ void xcd_barrier_impl(unsigned* bar_, unsigned bx, volatile LAS unsigned* st_) {
    XcdBarrier b; b.bar = bar_; b.x = bx; b.st = st_;
    asm volatile("s_waitcnt vmcnt(0)" ::: "memory");
    __syncthreads();
    if (threadIdx.x == 0) {
        unsigned* bar = b.bar;
        __builtin_amdgcn_s_waitcnt(0);
        unsigned nloc = b.st[0], nx = b.st[1];
        if (nloc == 0u) { xcd_barrier_complete(bar, b.x, nloc, nx); b.st[0] = nloc; b.st[1] = nx; }
        const unsigned old = xb_add(&bar[XB_XSUB(b.x)], 1u);
        const unsigned gen = old / nloc;
        if (old + 1u == (gen + 1u) * nloc) {
            __builtin_amdgcn_fence(__ATOMIC_RELEASE, "agent");
            asm volatile("s_waitcnt vmcnt(0)" ::: "memory");
            const unsigned og = xb_add(&bar[XB_TOP], 1u);
            const unsigned tg = og / nx;
            if (og + 1u == (tg + 1u) * nx) xb_add(&bar[XB_TOPGEN], 1u);
            else XB_SPIN(xb_ld(&bar[XB_TOPGEN]) == tg, bar);
            __builtin_amdgcn_fence(__ATOMIC_ACQUIRE, "agent");
            xb_add(&bar[XB_XGEN(b.x)], 1u);
            asm volatile("s_waitcnt vmcnt(0)" ::: "memory");
        } else {
            XB_SPIN(xb_ld(&bar[XB_XGEN(b.x)]) == gen, bar);
            __builtin_amdgcn_fence(__ATOMIC_ACQUIRE, "agent");
            asm volatile("s_waitcnt vmcnt(0)" ::: "memory");
        }
    }
    __syncthreads();
}

namespace pg8 {
constexpr int BM = 256, BK = 64, HALF = 128, HTB = HALF * BK * 2, STAGE_BYTES = 8 * HTB, NXCD = 8, WGM = 8;
__host__ __device__ __forceinline__ int lds_byte(int r, int c) { const int st = (r >> 4) * 2 + (c >> 5), rr = r & 15, cc = c & 31, ob = rr * 64 + cc * 2; return st * 1024 + (ob ^ (((ob >> 9) & 1) << 5)); }
__host__ __device__ __forceinline__ void stage_rc(int b, int& R, int& C) { const int st = b / 1024, sb = b % 1024, swz = sb ^ (((sb >> 9) & 1) << 5); R = (st >> 1) * 16 + swz / 64; C = (st & 1) * 32 + (swz % 64) / 2; }
__host__ __device__ __forceinline__ int perm32(int rho) { const int n = rho >> 4, i = rho & 15; return 8 * (i >> 2) + 4 * n + (i & 3); }

struct Unit { int pm, pn, am, ex; size_t bo; };
typedef int i32x4 __attribute__((ext_vector_type(4)));
typedef int i32x8 __attribute__((ext_vector_type(8)));
typedef short bf16x16 __attribute__((ext_vector_type(16)));
struct Gemm { const bf16_t* A; const bf16_t* Bt; int K; int lda, ldb; };

__device__ __forceinline__ bool tile_of(long L, int nM, int nN, int& pm, int& pn) {
    const int nwg = nM * nN; if (L >= nwg) return false;
    int wgid = (int)L; { const int q = nwg / NXCD, r = nwg % NXCD, xcd = wgid % NXCD, off = wgid / NXCD; wgid = (xcd < r ? xcd * (q + 1) : r * (q + 1) + (xcd - r) * q) + off; }
    const int nig = WGM * nN, gid = wgid / nig, fm = gid * WGM, gsz = (nM - fm) < WGM ? (nM - fm) : WGM;
    pm = fm + ((wgid % nig) % gsz); pn = (wgid % nig) / gsz; return true;
}
struct RowOrder {
    int nM, nN, G, c, latent_only;
    __device__ __forceinline__ bool next(int i, Unit& u) const {
        int pm, pn; if (!tile_of((long)i * G + c, nM, nN, pm, pn)) return false;
        if (latent_only) pm = (pm >> 3) * 9 + 1 + (pm & 7);
        u.pm = pm; u.am = pm; u.pn = pn; u.bo = 0; u.ex = 0; return true;
    }
};
struct MoeOrder {
    int nM, nN, G, c, t0, a_rel, o_rel; const unsigned* tile_expert; size_t expert_bytes;
    __device__ __forceinline__ bool next(int i, Unit& u) const {
        int pm, pn; if (nM <= 0 || !tile_of((long)i * G + c, nM, nN, pm, pn)) return false;
        u.pm = o_rel ? pm : t0 + pm; u.am = a_rel ? pm : t0 + pm; u.pn = pn; u.ex = (int)tile_expert[t0 + pm]; u.bo = (size_t)u.ex * expert_bytes; return true;
    }
};

template <int MODE, int N> struct FragSet { bf16x8 s[N][2]; };
template <int N> struct FragSet<2, N> { bf16x16 w[N]; };
template <class Epi, class Sched, int MODE = 0>
__device__ __forceinline__ void gemm_phase(LAS unsigned char* lds, const Gemm g, const Sched& S, const Epi& E) {
    int tid_ = threadIdx.x; asm volatile("" : "+v"(tid_));
    const int tid = tid_, wid = __builtin_amdgcn_readfirstlane(tid >> 6), lane = tid & 63, wr = wid >> 2, wc = wid & 3, fr = lane & 15, fq = lane >> 4;
    constexpr bool I8 = MODE == 1;
    int f8scale = 0x7f7f7f7f; asm volatile("" : "+v"(f8scale));
    const int K = g.K, nt = K / BK, lda = g.lda ? g.lda : K, ldb = g.ldb ? g.ldb : K;
    unsigned voffA[2], voffB[2];
#pragma unroll
    for (int i = 0; i < 2; ++i) { int R, C; stage_rc(tid * 16 + i * 8192, R, C); const int Rb = Epi::PERM ? ((R & ~31) + perm32(R & 31)) : R;
        voffA[i] = (unsigned)(R * lda + C) * 2u; voffB[i] = (unsigned)(Rb * ldb + C) * 2u; }
    const size_t kstep = (size_t)(BK * 2);
    const size_t hstepA = (size_t)HALF * lda * 2, hstepB = (size_t)HALF * ldb * 2;
    const size_t tstepA = 2 * hstepA, tstepB = 2 * hstepB;
    const unsigned ldsw = (unsigned)wid * 1024u;
    const int aoff = lds_byte(wr * 64 + fr, fq * 8), boff = lds_byte(wc * 32 + fr, fq * 8);
#define PG8_SA(b, h) (((b) * 2 + (h)) * HTB)
#define PG8_SB(b, h) ((4 + (b) * 2 + (h)) * HTB)
#define PG8_STAGE(bufoff, gbase, voff) do { _Pragma("unroll") for (int _i = 0; _i < 2; ++_i) \
        __builtin_amdgcn_global_load_lds((const unsigned*)((const char*)(gbase) + (voff)[_i]), (LAS unsigned*)(lds + (bufoff) + ldsw + _i * 8192), 16, 0, 0); } while (0)
#define PG8_LDA(dst, b, h) do { if constexpr (MODE == 2) { _Pragma("unroll") for (int m = 0; m < 4; ++m) dst.w[m] = __builtin_shufflevector(*(const LAS bf16x8*)(lds + PG8_SA(b, h) + aoff + m * 2048), *(const LAS bf16x8*)(lds + PG8_SA(b, h) + aoff + m * 2048 + 1024), 0, 1, 2, 3, 4, 5, 6, 7, 8, 9, 10, 11, 12, 13, 14, 15); } \
        else { _Pragma("unroll") for (int m = 0; m < 4; ++m) _Pragma("unroll") for (int k = 0; k < 2; ++k) dst.s[m][k] = *(const LAS bf16x8*)(lds + PG8_SA(b, h) + aoff + m * 2048 + k * 1024); } } while (0)
#define PG8_LDB(dst, b, h) do { if constexpr (MODE == 2) { _Pragma("unroll") for (int n = 0; n < 2; ++n) dst.w[n] = __builtin_shufflevector(*(const LAS bf16x8*)(lds + PG8_SB(b, h) + boff + n * 2048), *(const LAS bf16x8*)(lds + PG8_SB(b, h) + boff + n * 2048 + 1024), 0, 1, 2, 3, 4, 5, 6, 7, 8, 9, 10, 11, 12, 13, 14, 15); } \
        else { _Pragma("unroll") for (int n = 0; n < 2; ++n) _Pragma("unroll") for (int k = 0; k < 2; ++k) dst.s[n][k] = *(const LAS bf16x8*)(lds + PG8_SB(b, h) + boff + n * 2048 + k * 1024); } } while (0)
#define PG8_MMA(ai, bj, At, Bt) do { __builtin_amdgcn_s_setprio(1); \
        if constexpr (MODE == 2) { _Pragma("unroll") for (int m = 0; m < 4; ++m) _Pragma("unroll") for (int n = 0; n < 2; ++n) \
            asm volatile("v_mfma_scale_f32_16x16x128_f8f6f4 %0, %1, %2, %0, %3, %3 op_sel_hi:[0,0,0]" : "+v"(acc[ai][bj][m][n]) : "v"(__builtin_bit_cast(i32x8, Bt.w[n])), "v"(__builtin_bit_cast(i32x8, At.w[m])), "v"(f8scale)); } \
        else { _Pragma("unroll") for (int m = 0; m < 4; ++m) _Pragma("unroll") for (int n = 0; n < 2; ++n) _Pragma("unroll") for (int k = 0; k < 2; ++k) \
        { if constexpr (I8) acc[ai][bj][m][n] = __builtin_bit_cast(f32x4, __builtin_amdgcn_mfma_i32_16x16x64_i8(__builtin_bit_cast(i32x4, Bt.s[n][k]), __builtin_bit_cast(i32x4, At.s[m][k]), __builtin_bit_cast(i32x4, acc[ai][bj][m][n]), 0, 0, 0)); \
          else acc[ai][bj][m][n] = __builtin_amdgcn_mfma_f32_16x16x32_bf16(Bt.s[n][k], At.s[m][k], acc[ai][bj][m][n], 0, 0, 0); } } __builtin_amdgcn_s_setprio(0); } while (0)
#define PG8_WAIT_V(n) asm volatile("s_waitcnt vmcnt(" #n ")" ::: "memory")
#define PG8_WAIT_L(n) asm volatile("s_waitcnt lgkmcnt(" #n ")" ::: "memory")
#define PG8_BAR __builtin_amdgcn_s_barrier()
#define PG8_SCHED __builtin_amdgcn_sched_barrier(0)
    Unit cur, nxt; int ui = 0;
    if (!S.next(0, cur)) return;
    constexpr int PRE_BASE = STAGE_BYTES;
#define PG8_PRE(u_, sel_) do { if constexpr (Epi::NPRE > 0) { if (wid == 0) { _Pragma("unroll") for (int k_ = 0; k_ < Epi::NPRE; ++k_) \
        __builtin_amdgcn_global_load_lds((const unsigned*)(E.pre_src(u_, k_) + lane * 4), (LAS unsigned*)(lds + PRE_BASE + (sel_) * 2048 + k_ * 1024), 16, 0, 0); } } } while (0)
    PG8_PRE(cur, 0);
    f32x4 acc[2][2][4][2];
#pragma unroll
    for (int a = 0; a < 2; ++a)
#pragma unroll
        for (int b = 0; b < 2; ++b)
#pragma unroll
            for (int m = 0; m < 4; ++m)
#pragma unroll
                for (int n = 0; n < 2; ++n) acc[a][b][m][n] = (f32x4){0.f, 0.f, 0.f, 0.f};
    FragSet<MODE, 4> At; FragSet<MODE, 2> B0, B1;
    const char* cA = (const char*)g.A + (size_t)cur.am * tstepA; const char* cB = (const char*)g.Bt + cur.bo + (size_t)cur.pn * tstepB;
    PG8_STAGE(PG8_SB(0, 0), cB, voffB); PG8_STAGE(PG8_SA(0, 0), cA, voffA); PG8_STAGE(PG8_SB(0, 1), cB + hstepB, voffB); PG8_STAGE(PG8_SA(0, 1), cA + hstepA, voffA);
    if (wr == 1) PG8_BAR;
    PG8_WAIT_V(4); PG8_BAR;
    PG8_STAGE(PG8_SB(1, 0), cB + kstep, voffB); PG8_STAGE(PG8_SA(1, 0), cA + kstep, voffA); PG8_STAGE(PG8_SB(1, 1), cB + hstepB + kstep, voffB);
    PG8_WAIT_V(6); PG8_BAR;
    for (;;) {
        const bool has_next = S.next(ui + 1, nxt);
        const char* nA = has_next ? (const char*)g.A + (size_t)nxt.am * tstepA : cA; const char* nB = has_next ? (const char*)g.Bt + nxt.bo + (size_t)nxt.pn * tstepB : cB;
        for (int t = 0; t < nt; t += 2) {
            const bool last = (t == nt - 2);
            const char* a1 = cA + (size_t)(t + 1) * kstep;
            const char* a2 = last ? nA : cA + (size_t)(t + 2) * kstep; const char* b2 = last ? nB : cB + (size_t)(t + 2) * kstep;
            const char* a3 = a2 + kstep; const char* b3 = b2 + kstep;
            PG8_LDB(B0, 0, 0); PG8_SCHED; PG8_LDA(At, 0, 0); PG8_STAGE(PG8_SA(1, 1), a1 + hstepA, voffA);
            PG8_WAIT_L(8); PG8_BAR; PG8_WAIT_L(0); PG8_MMA(0, 0, At, B0); PG8_BAR; PG8_SCHED;
            PG8_LDB(B1, 0, 1); PG8_STAGE(PG8_SB(0, 0), b2, voffB);
            PG8_BAR; PG8_WAIT_L(0); PG8_MMA(0, 1, At, B1); PG8_BAR;
            PG8_LDA(At, 0, 1); PG8_STAGE(PG8_SA(0, 0), a2, voffA);
            PG8_BAR; PG8_WAIT_L(0); PG8_MMA(1, 0, At, B0); PG8_BAR; PG8_SCHED;
            PG8_STAGE(PG8_SB(0, 1), b2 + hstepB, voffB);
            PG8_WAIT_V(6); PG8_BAR; PG8_MMA(1, 1, At, B1); PG8_BAR;
            PG8_LDB(B0, 1, 0); PG8_SCHED; PG8_LDA(At, 1, 0); PG8_STAGE(PG8_SA(0, 1), a2 + hstepA, voffA);
            PG8_WAIT_L(8); PG8_BAR; PG8_WAIT_L(0); PG8_MMA(0, 0, At, B0); PG8_BAR; PG8_SCHED;
            PG8_LDB(B1, 1, 1); PG8_STAGE(PG8_SB(1, 0), b3, voffB);
            PG8_BAR; PG8_WAIT_L(0); PG8_MMA(0, 1, At, B1); PG8_BAR;
            PG8_LDA(At, 1, 1); PG8_STAGE(PG8_SA(1, 0), a3, voffA);
            PG8_BAR; PG8_WAIT_L(0); PG8_MMA(1, 0, At, B0); PG8_BAR; PG8_SCHED;
            PG8_STAGE(PG8_SB(1, 1), b3 + hstepB, voffB);
            PG8_WAIT_V(6); PG8_BAR; PG8_MMA(1, 1, At, B1); PG8_BAR;
        }
        if constexpr (MODE == 2) asm volatile("s_nop 15\n\ts_nop 15" ::: "memory");
        if constexpr (I8) {
#pragma unroll
            for (int a = 0; a < 2; ++a)
#pragma unroll
                for (int b = 0; b < 2; ++b)
#pragma unroll
                    for (int m = 0; m < 4; ++m)
#pragma unroll
                        for (int n = 0; n < 2; ++n) { const i32x4 iv = __builtin_bit_cast(i32x4, acc[a][b][m][n]); acc[a][b][m][n] = (f32x4){(float)iv[0], (float)iv[1], (float)iv[2], (float)iv[3]}; }
        }
        if (has_next) PG8_PRE(nxt, (ui + 1) & 1);
        { int fr2 = fr, fq2 = fq; asm volatile("" : "+v"(fr2), "+v"(fq2));
          E(acc, cur, wr, wc, fr2, fq2, (const LAS float*)(lds + PRE_BASE + (ui & 1) * 2048)); }
        if (!has_next) break;
#pragma unroll
        for (int a = 0; a < 2; ++a)
#pragma unroll
            for (int b = 0; b < 2; ++b)
#pragma unroll
                for (int m = 0; m < 4; ++m)
#pragma unroll
                    for (int n = 0; n < 2; ++n) acc[a][b][m][n] = (f32x4){0.f, 0.f, 0.f, 0.f};
        cur = nxt; cA = nA; cB = nB; ++ui;
    }
    PG8_WAIT_V(0);
    if (wr == 0) PG8_BAR;
    PG8_BAR;
#undef PG8_SA
#undef PG8_SB
#undef PG8_STAGE
#undef PG8_LDA
#undef PG8_LDB
#undef PG8_MMA
#undef PG8_PRE
#undef PG8_WAIT_V
#undef PG8_WAIT_L
#undef PG8_BAR
#undef PG8_SCHED
}
}
using pg8::Unit;

typedef const float* const __attribute__((address_space(4)))* intab_t;
struct Frame {
    intab_t in; unsigned char* ws; unsigned* ctl; float* out;
    int tid, lane, wid, G, bid;
};
#define WSP(T, off) ((T*)(F.ws + (off)))
typedef const Args __attribute__((address_space(4)))* kargs_t;
__device__ __forceinline__ kargs_t kargs() { unsigned long long p = (unsigned long long)__builtin_amdgcn_kernarg_segment_ptr(); asm volatile("" : "+s"(p)); return (kargs_t)p; }
__device__ __forceinline__ Frame make_frame() {
    Frame F; kargs_t ka = kargs(); F.in = (intab_t)ka; F.ws = ka->ws; F.ctl = (unsigned*)(ka->ws + WS_CTL); F.out = ka->out;
    int t = threadIdx.x; asm volatile("" : "+v"(t)); F.tid = t; F.lane = t & 63; F.wid = __builtin_amdgcn_readfirstlane(t >> 6); F.G = gridDim.x; F.bid = blockIdx.x; return F;
}

__device__ __forceinline__ void rope4(f32x4& v0, f32x4& v1, const f32x4* tab) {
    const f32x4 t0 = tab[0], t1 = tab[1];
    const float a0 = v0[0], b0 = v0[1], a1 = v0[2], b1 = v0[3], a2 = v1[0], b2 = v1[1], a3 = v1[2], b3 = v1[3];
    v0[0] = a0 * t0[0] - b0 * t0[1]; v0[1] = b0 * t0[0] + a0 * t0[1];
    v0[2] = a1 * t0[2] - b1 * t0[3]; v0[3] = b1 * t0[2] + a1 * t0[3];
    v1[0] = a2 * t1[0] - b2 * t1[1]; v1[1] = b2 * t1[0] + a2 * t1[1];
    v1[2] = a3 * t1[2] - b3 * t1[3]; v1[3] = b3 * t1[2] + a3 * t1[3];
}
struct EpiProj {
    static constexpr bool PERM = true; static constexpr int NPRE = 2;
    __device__ __forceinline__ const float* pre_src(const Unit& u, int k) const { return k == 0 ? cs + u.pn * 256 : rs + u.pm * 256; }
    bf16_t* P; const float* tabDA; const float* tabML; const float* rs; const float* cs; float* SS;
    __device__ __forceinline__ void operator()(const f32x4 (&acc)[2][2][4][2], const Unit& u, int wr, int wc, int fr, int fq, const LAS float* pre) const {
        const int kk = u.pm % 9; const bool latent = kk > 0;
        const int lane_ = fr + 16 * fq; float rsl[2];
#pragma unroll
        for (int ai = 0; ai < 2; ++ai) rsl[ai] = pre[256 + ai * 128 + wr * 64 + lane_];
#pragma unroll
        for (int bj = 0; bj < 2; ++bj) {
            const int col0 = u.pn * 256 + bj * 128 + wc * 32 + 8 * fq;
            if (col0 >= PLD) continue;
            int mode = 0, axis = 0, f0 = 0; float sc = 1.f;
            const f32x4 cs0 = *(const LAS f32x4*)(pre + bj * 128 + wc * 32 + 8 * fq), cs1 = *(const LAS f32x4*)(pre + bj * 128 + wc * 32 + 8 * fq + 4);
            if (col0 < C_DAV) { const int g = (col0 % 48) >> 3; mode = 1; axis = g / 3; f0 = (g % 3) * 4; if (col0 < C_DAK) sc = SC_DA; }
            else if (col0 >= C_KR) { const int g = (col0 - C_KR) >> 3; mode = 2; axis = g >> 1; f0 = (g & 1) * 4; }
            const bool dosum = u.pn == 7 ? bj == 1 : u.pn == 8; const int slot = u.pn == 7 ? 0 : 1 + bj;
#pragma unroll
            for (int ai = 0; ai < 2; ++ai) {
                float zsel = 0.f;
#pragma unroll
                for (int m = 0; m < 4; ++m) {
                    const int rl = ai * 128 + wr * 64 + m * 16 + fr;
                    const float rsv = __int_as_float(__builtin_amdgcn_ds_bpermute((m * 16 + fr) << 2, __float_as_int(rsl[ai])));
                    f32x4 v0 = acc[ai][bj][m][0] * cs0 * rsv, v1 = acc[ai][bj][m][1] * cs1 * rsv;
                    if (dosum) { float sq = ((v0[0] * v0[0] + v0[1] * v0[1]) + (v0[2] * v0[2] + v0[3] * v0[3])) + ((v1[0] * v1[0] + v1[1] * v1[1]) + (v1[2] * v1[2] + v1[3] * v1[3]));
                        { const auto r = __builtin_amdgcn_permlane16_swap(__float_as_uint(sq), __float_as_uint(sq), false, false); sq = __uint_as_float(r[0]) + __uint_as_float(r[1]); }
                        { const auto r = __builtin_amdgcn_permlane32_swap(__float_as_uint(sq), __float_as_uint(sq), false, false); sq = __uint_as_float(r[0]) + __uint_as_float(r[1]); }
                        if (fq == m) zsel = sq; }
                    if (mode && latent) {
                        const int t = (kk - 1) * 256 + rl; const int pos = axis ? (t & 63) : (t >> 6);
                        const f32x4* tab = mode == 1 ? (const f32x4*)(tabDA + (pos * 12 + f0) * 2) : (const f32x4*)(tabML + (pos * 8 + f0) * 2);
                        rope4(v0, v1, tab);
                    }
                    v0 *= sc; v1 *= sc;
                    u32x4 w; w.x = cvt_pk_bf16(v0[0], v0[1]); w.y = cvt_pk_bf16(v0[2], v0[3]); w.z = cvt_pk_bf16(v1[0], v1[1]); w.w = cvt_pk_bf16(v1[2], v1[3]);
                    *(u32x4*)(P + (size_t)(u.pm * 256 + rl) * PLD + col0) = w;
                    __builtin_amdgcn_sched_barrier(0);
                }
                if (dosum) SS[(size_t)(u.pm * 256 + ai * 128 + wr * 64 + lane_) * 16 + slot * 4 + wc] = zsel;
            }
        }
    }
};
struct EpiMlaQ {
    static constexpr bool PERM = true; static constexpr int NPRE = 0;
    bf16_t* Q; const float* tabML; const float* SS;
    __device__ __forceinline__ void operator()(const f32x4 (&acc)[2][2][4][2], const Unit& u, int wr, int wc, int fr, int fq, const LAS float* pre) const {
        const int kk = u.pm % 9; const bool latent = kk > 0;
        const int lane_ = fr + 16 * fq; float rsl[2];
#pragma unroll
        for (int ai = 0; ai < 2; ++ai) { const f32x4* sp = (const f32x4*)(SS + (size_t)(u.pm * 256 + ai * 128 + wr * 64 + lane_) * 16); const f32x4 a = sp[0], b = sp[1];
            rsl[ai] = __builtin_amdgcn_rsqf((((a[0] + a[1]) + (a[2] + a[3])) + ((b[0] + b[1]) + (b[2] + b[3]))) * (1.0f / 256.0f) + RMS_EPS) * SC_ML; }
#pragma unroll
        for (int bj = 0; bj < 2; ++bj) {
            const int col0 = u.pn * 256 + bj * 128 + wc * 32 + 8 * fq;
            if (col0 >= MQLD) continue;
            const int d0 = col0 % 96; int mode = 0, axis = 0, f0 = 0;
            if (d0 >= 64) { const int g = (d0 - 64) >> 3; mode = 1; axis = g >> 1; f0 = (g & 1) * 4; }
#pragma unroll
            for (int ai = 0; ai < 2; ++ai)
#pragma unroll
                for (int m = 0; m < 4; ++m) {
                    const int rl = ai * 128 + wr * 64 + m * 16 + fr;
                    const float rsv = __int_as_float(__builtin_amdgcn_ds_bpermute((m * 16 + fr) << 2, __float_as_int(rsl[ai])));
                    f32x4 v0 = acc[ai][bj][m][0] * rsv, v1 = acc[ai][bj][m][1] * rsv;
                    if (mode && latent) {
                        const int t = (kk - 1) * 256 + rl; const int pos = axis ? (t & 63) : (t >> 6);
                        rope4(v0, v1, (const f32x4*)(tabML + (pos * 8 + f0) * 2));
                    }
                    u32x4 w; w.x = cvt_pk_bf16(v0[0], v0[1]); w.y = cvt_pk_bf16(v0[2], v0[3]); w.z = cvt_pk_bf16(v1[0], v1[1]); w.w = cvt_pk_bf16(v1[2], v1[3]);
                    *(u32x4*)(Q + (size_t)(u.pm * 256 + rl) * MQLD + col0) = w;
                    __builtin_amdgcn_sched_barrier(0);
                }
        }
    }
};
struct EpiBf16 {
    static constexpr bool PERM = true; static constexpr int NPRE = 1;
    __device__ __forceinline__ const float* pre_src(const Unit& u, int) const { return cs + (size_t)u.ex * 1024 + u.pn * 256; }
    bf16_t* O; int ldc; const float* cs; float mul;
    __device__ __forceinline__ void operator()(const f32x4 (&acc)[2][2][4][2], const Unit& u, int wr, int wc, int fr, int fq, const LAS float* pre) const {
#pragma unroll
        for (int bj = 0; bj < 2; ++bj) {
            const int col0 = u.pn * 256 + bj * 128 + wc * 32 + 8 * fq;
            const f32x4 c0 = *(const LAS f32x4*)(pre + bj * 128 + wc * 32 + 8 * fq) * mul, c1 = *(const LAS f32x4*)(pre + bj * 128 + wc * 32 + 8 * fq + 4) * mul;
#pragma unroll
            for (int ai = 0; ai < 2; ++ai)
#pragma unroll
                for (int m = 0; m < 4; ++m) {
                    const int rl = ai * 128 + wr * 64 + m * 16 + fr;
                    const f32x4 v0 = acc[ai][bj][m][0] * c0, v1 = acc[ai][bj][m][1] * c1;
                    u32x4 w; w.x = cvt_pk_bf16(v0[0], v0[1]); w.y = cvt_pk_bf16(v0[2], v0[3]); w.z = cvt_pk_bf16(v1[0], v1[1]); w.w = cvt_pk_bf16(v1[2], v1[3]);
                    *(u32x4*)(O + (size_t)(u.pm * 256 + rl) * ldc + col0) = w;
                }
        }
    }
};
struct EpiMlaKV {
    static constexpr bool PERM = true; static constexpr int NPRE = 0;
    bf16_t* O; const float* SS;
    __device__ __forceinline__ void operator()(const f32x4 (&acc)[2][2][4][2], const Unit& u, int wr, int wc, int fr, int fq, const LAS float* pre) const {
        const int lane_ = fr + 16 * fq; float rsl[2];
#pragma unroll
        for (int ai = 0; ai < 2; ++ai) { const f32x4 a = *(const f32x4*)(SS + (size_t)(u.pm * 256 + ai * 128 + wr * 64 + lane_) * 16 + 8);
            rsl[ai] = __builtin_amdgcn_rsqf(((a[0] + a[1]) + (a[2] + a[3])) * (1.0f / 128.0f) + RMS_EPS); }
#pragma unroll
        for (int bj = 0; bj < 2; ++bj) {
            const int col0 = u.pn * 256 + bj * 128 + wc * 32 + 8 * fq;
#pragma unroll
            for (int ai = 0; ai < 2; ++ai)
#pragma unroll
                for (int m = 0; m < 4; ++m) {
                    const int rl = ai * 128 + wr * 64 + m * 16 + fr;
                    const float rsv = __int_as_float(__builtin_amdgcn_ds_bpermute((m * 16 + fr) << 2, __float_as_int(rsl[ai])));
                    const f32x4 v0 = acc[ai][bj][m][0] * rsv, v1 = acc[ai][bj][m][1] * rsv;
                    u32x4 w; w.x = cvt_pk_bf16(v0[0], v0[1]); w.y = cvt_pk_bf16(v0[2], v0[3]); w.z = cvt_pk_bf16(v1[0], v1[1]); w.w = cvt_pk_bf16(v1[2], v1[3]);
                    *(u32x4*)(O + (size_t)(u.pm * 256 + rl) * MKVLD + col0) = w;
                    __builtin_amdgcn_sched_barrier(0);
                }
        }
    }
};
struct EpiSwiglu {
    static constexpr bool PERM = true; static constexpr int NPRE = 2;
    __device__ __forceinline__ const float* pre_src(const Unit& u, int k) const { return k == 0 ? cs + (size_t)u.ex * 5632 + u.pn * 256 : rs + u.am * 256; }
    unsigned char* H; const float* rs; const float* cs;
    __device__ __forceinline__ void operator()(const f32x4 (&acc)[2][2][4][2], const Unit& u, int wr, int wc, int fr, int fq, const LAS float* pre) const {
        const int col0 = u.pn * 128 + wc * 32 + 8 * fq; const int rt = u.pm;
        const float* csp = cs + (size_t)u.ex * 5632 + u.pn * 256 + wc * 32 + 8 * fq;
        f32x4 cg[2], cu[2];
#pragma unroll
        for (int n = 0; n < 2; ++n) { cg[n] = *(const LAS f32x4*)(pre + wc * 32 + 8 * fq + 4 * n) * LOG2E; cu[n] = *(const LAS f32x4*)(pre + 128 + wc * 32 + 8 * fq + 4 * n) * (HSCL / LOG2E); }
        const int lane_ = fr + 16 * fq; float rsl[2];
#pragma unroll
        for (int ai = 0; ai < 2; ++ai) rsl[ai] = pre[256 + ai * 128 + wr * 64 + lane_];
#pragma unroll
        for (int ai = 0; ai < 2; ++ai)
#pragma unroll
            for (int mp = 0; mp < 2; ++mp) {
                u32x2 w[2];
#pragma unroll
                for (int q = 0; q < 2; ++q) { const int m = 2 * mp + q;
                    const int rl = ai * 128 + wr * 64 + m * 16 + fr;
                    float h[8]; const float rsv = __int_as_float(__builtin_amdgcn_ds_bpermute((m * 16 + fr) << 2, __float_as_int(rsl[ai])));
#pragma unroll
                    for (int n = 0; n < 2; ++n)
#pragma unroll
                        for (int e = 0; e < 4; ++e) { const float gv = acc[ai][0][m][n][e] * cg[n][e] * rsv, uv = acc[ai][1][m][n][e] * cu[n][e] * rsv;
                            const float sg = gv * __builtin_amdgcn_rcpf(1.0f + fast_exp2(-gv));
                            h[n * 4 + e] = __builtin_amdgcn_fmed3f(sg * uv, -448.0f, 448.0f); }
                    int t0 = __builtin_amdgcn_cvt_pk_fp8_f32(h[0], h[1], 0, false); t0 = __builtin_amdgcn_cvt_pk_fp8_f32(h[2], h[3], t0, true);
                    int t1 = __builtin_amdgcn_cvt_pk_fp8_f32(h[4], h[5], 0, false); t1 = __builtin_amdgcn_cvt_pk_fp8_f32(h[6], h[7], t1, true); w[q].x = (unsigned)t0; w[q].y = (unsigned)t1; }
                const auto r0 = __builtin_amdgcn_permlane16_swap(w[0].x, w[1].x, false, false); const auto r1 = __builtin_amdgcn_permlane16_swap(w[0].y, w[1].y, false, false);
                const int rl2 = ai * 128 + wr * 64 + (2 * mp + (fq & 1)) * 16 + fr;
                *(u32x4*)(H + (size_t)(rt * 256 + rl2) * FF + col0 - 8 * (fq & 1)) = (u32x4){r0[0], r1[0], r0[1], r1[1]};
            }
    }
};
template <bool FIRST = false>
struct EpiResid {
    static constexpr bool PERM = true; static constexpr int NPRE = 0;
    bf16_t* Y; const bf16_t* XH; const float* gate; const float* cs; float mul;
    __device__ __forceinline__ void operator()(const f32x4 (&acc)[2][2][4][2], const Unit& u, int wr, int wc, int fr, int fq, const LAS float* pre) const {
        const int b = u.pm / 9, kk = u.pm % 9; const float* gp = gate + (size_t)(kk ? b : 16) * 6144;
        const int col0 = u.pn * 256 + wc * 32 + 8 * fq;
        const float* src0 = nullptr;
        if (FIRST) { kargs_t ka = kargs(); src0 = kk ? ka->in[0] + ((size_t)b * SEQ + (size_t)(kk - 1) * 256) * 1024 : ka->in[2] + (size_t)b * CTXL * 1024; }
        f32x4 gv[2][2];
#pragma unroll
        for (int bj = 0; bj < 2; ++bj)
#pragma unroll
            for (int n = 0; n < 2; ++n) { gv[bj][n] = *(const f32x4*)(gp + col0 + bj * 128 + n * 4); if (cs) gv[bj][n] *= *(const f32x4*)(cs + col0 + bj * 128 + n * 4) * mul; }
        if (!FIRST) {
            u32x4 hres[2][4][2];
#pragma unroll
            for (int ai = 0; ai < 2; ++ai)
#pragma unroll
                for (int m = 0; m < 4; ++m)
#pragma unroll
                    for (int bj = 0; bj < 2; ++bj) hres[ai][m][bj] = *(const u32x4*)(XH + (size_t)(u.pm * 256 + ai * 128 + wr * 64 + m * 16 + fr) * 1024 + col0 + bj * 128);
            __builtin_amdgcn_sched_barrier(0);
#pragma unroll
            for (int ai = 0; ai < 2; ++ai)
#pragma unroll
                for (int m = 0; m < 4; ++m) {
                    const size_t ro = (size_t)(u.pm * 256 + ai * 128 + wr * 64 + m * 16 + fr) * 1024 + col0;
#pragma unroll
                    for (int bj = 0; bj < 2; ++bj) {
                        const u32x4 h = hres[ai][m][bj]; const f32x2 a0 = unpk_f16(h.x), a1 = unpk_f16(h.y), a2 = unpk_f16(h.z), a3 = unpk_f16(h.w);
                        const f32x4 r0 = {a0[0], a0[1], a1[0], a1[1]}, r1 = {a2[0], a2[1], a3[0], a3[1]};
                        const f32x4 y0 = r0 * ALPHA + gv[bj][0] * acc[ai][bj][m][0], y1 = r1 * ALPHA + gv[bj][1] * acc[ai][bj][m][1];
                        u32x4 w; w.x = cvt_pk_f16(y0[0], y0[1]); w.y = cvt_pk_f16(y0[2], y0[3]); w.z = cvt_pk_f16(y1[0], y1[1]); w.w = cvt_pk_f16(y1[2], y1[3]);
                        *(u32x4*)(Y + ro + bj * 128) = w;
                    }
                    __builtin_amdgcn_sched_barrier(0);
                }
        } else {
#pragma unroll
            for (int ai = 0; ai < 2; ++ai) {
                f32x4 fres[4][2][2];
#pragma unroll
                for (int m = 0; m < 4; ++m)
#pragma unroll
                    for (int bj = 0; bj < 2; ++bj) { const float* sp = src0 + (size_t)(ai * 128 + wr * 64 + m * 16 + fr) * 1024 + col0 + bj * 128; fres[m][bj][0] = *(const f32x4*)sp; fres[m][bj][1] = *(const f32x4*)(sp + 4); }
                __builtin_amdgcn_sched_barrier(0);
#pragma unroll
                for (int m = 0; m < 4; ++m) {
                    const size_t ro = (size_t)(u.pm * 256 + ai * 128 + wr * 64 + m * 16 + fr) * 1024 + col0;
#pragma unroll
                    for (int bj = 0; bj < 2; ++bj) {
                        const f32x4 y0 = fres[m][bj][0] * ALPHA + gv[bj][0] * acc[ai][bj][m][0], y1 = fres[m][bj][1] * ALPHA + gv[bj][1] * acc[ai][bj][m][1];
                        u32x4 w; w.x = cvt_pk_f16(y0[0], y0[1]); w.y = cvt_pk_f16(y0[2], y0[3]); w.z = cvt_pk_f16(y1[0], y1[1]); w.w = cvt_pk_f16(y1[2], y1[3]);
                        *(u32x4*)(Y + ro + bj * 128) = w;
                    }
                    __builtin_amdgcn_sched_barrier(0);
                }
            }
        }
    }
};

__device__ __forceinline__ int map_win(int n) {
    if (n < C_DAV) { const int base = n >= C_DAK ? C_DAK : 0; const int r = n - base; const int hd = r / 96, rem = r % 96, mp = rem / 48, r48 = rem % 48, half = r48 / 24, p = r48 % 24;
        return base + hd * 96 + mp * 48 + half * 24 + (p >> 1) + 12 * (p & 1); }
    if (n < C_KR) return n;
    if (n < PLD) { const int p = n - C_KR, half = p >> 4, pp = p & 15; return C_KR + half * 16 + (pp >> 1) + 8 * (pp & 1); }
    return -1;
}
__device__ __forceinline__ int map_uq(int n) {
    if (n >= MQLD) return -1;
    const int hd = n / 96, d = n % 96; if (d < 64) return n;
    const int p = d - 64, half = p >> 4, pp = p & 15; return hd * 96 + 64 + half * 16 + (pp >> 1) + 8 * (pp & 1);
}
__device__ __forceinline__ int map_gu(int n) { const int t = n >> 8, bj = (n >> 7) & 1, j = n & 127; return (t * 128 + j) | (bj << 30); }
__device__ __forceinline__ int map_id(int n) { return n; }

template <int MAPID>
__device__ __forceinline__ void convert_tile(const Frame& F, LAS float* tile, const float* src0, const float* src1, int Nsrc, int K, bf16_t* dst, int Kd, const float* kscale, int n0, int k0) {
    if (MAPID >= 2) {
        const int c4 = F.tid & 15, kr = F.tid >> 4;
        const int col = MAPID == 2 ? map_gu(n0) : n0; const float* src = (col & (1 << 30)) ? src1 : src0; const int cb = (col & ~(1 << 30)) + 4 * c4;
        f32x4 v[8];
#pragma unroll
        for (int i = 0; i < 8; ++i) { const int k = k0 + kr + 32 * i; v[i] = k < K ? *(const f32x4*)(src + (size_t)k * Nsrc + cb) : (f32x4){0.f, 0.f, 0.f, 0.f}; }
#pragma unroll
        for (int i = 0; i < 8; ++i) { const int kk = kr + 32 * i; float sc = 1.f; if (kscale) sc = (k0 + kk) < K ? kscale[k0 + kk] : 0.f;
            tile[kk * 65 + 4 * c4 + 0] = v[i][0] * sc; tile[kk * 65 + 4 * c4 + 1] = v[i][1] * sc; tile[kk * 65 + 4 * c4 + 2] = v[i][2] * sc; tile[kk * 65 + 4 * c4 + 3] = v[i][3] * sc; }
    } else {
        const int nn = F.tid & 63, kq = F.tid >> 6;
        const int col = MAPID == 0 ? map_win(n0 + nn) : map_uq(n0 + nn);
        float v[32];
#pragma unroll
        for (int i = 0; i < 32; ++i) { const int k = k0 + kq + 8 * i; v[i] = (col >= 0 && k < K) ? src0[(size_t)k * Nsrc + col] : 0.f; }
#pragma unroll
        for (int i = 0; i < 32; ++i) { const int kk = kq + 8 * i; float sc = 1.f; if (kscale) sc = (k0 + kk) < K ? kscale[k0 + kk] : 0.f; tile[kk * 65 + nn] = v[i] * sc; }
    }
    __syncthreads();
    { const int n = F.tid >> 3, kc = F.tid & 7;
#pragma unroll
      for (int i = 0; i < 4; ++i) { const int k8 = (kc + 8 * i) * 8; float v[8];
#pragma unroll
          for (int j = 0; j < 8; ++j) v[j] = tile[(k8 + j) * 65 + n];
          u32x4 w; w.x = cvt_pk_bf16(v[0], v[1]); w.y = cvt_pk_bf16(v[2], v[3]); w.z = cvt_pk_bf16(v[4], v[5]); w.w = cvt_pk_bf16(v[6], v[7]);
          *(u32x4*)(dst + (size_t)(n0 + n) * Kd + k0 + k8) = w; } }
    __syncthreads();
}
template <int MAPID>
__device__ __forceinline__ void convert_matrix(const Frame& F, LAS float* tile, const float* src0, const float* src1, int Nsrc, int K, bf16_t* dst, int Kd, int nrows, const float* kscale, int rot) {
    const int kt = Kd / 256, ntile = (nrows / 64) * kt;
    int u0 = F.bid - rot; if (u0 < 0) u0 += F.G;
    for (int u = u0; u < ntile; u += F.G) convert_tile<MAPID>(F, tile, src0, src1, Nsrc, K, dst, Kd, kscale, (u / kt) * 64, (u % kt) * 256);
}
template <int MAPID, int FMT = 0, int KTOT = 1024>
__device__ __forceinline__ void convert_unit_i8(const Frame& F, LAS float* tile, const float* src0, const float* src1, int Nsrc, signed char* dst, float* scl, int n0) {
    constexpr float QMAX = FMT ? 224.0f : 127.0f;
    LAS unsigned* cmax = (LAS unsigned*)(tile + 256 * 65);
    if (F.tid < 64) cmax[F.tid] = 0u;
    __syncthreads();
    const int c4 = F.tid & 15, kr = F.tid >> 4, nn = F.tid & 63, kq = F.tid >> 6;
    int colv = 0; const float* srcv = src0; int cols = 0;
    if (MAPID >= 2) { const int col = MAPID == 2 ? map_gu(n0) : n0; srcv = (col & (1 << 30)) ? src1 : src0; colv = (col & ~(1 << 30)) + 4 * c4; }
    else cols = map_win(n0 + nn);
#pragma unroll 1
    for (int sweep = 0; sweep < 2; ++sweep) {
        float iv0 = 0.f, iv1 = 0.f, iv2 = 0.f, iv3 = 0.f;
        if (sweep) { if (MAPID >= 2) { const float m0 = __uint_as_float(cmax[4 * c4]), m1 = __uint_as_float(cmax[4 * c4 + 1]), m2 = __uint_as_float(cmax[4 * c4 + 2]), m3 = __uint_as_float(cmax[4 * c4 + 3]);
                iv0 = m0 > 0.f ? QMAX / m0 : 0.f; iv1 = m1 > 0.f ? QMAX / m1 : 0.f; iv2 = m2 > 0.f ? QMAX / m2 : 0.f; iv3 = m3 > 0.f ? QMAX / m3 : 0.f; }
            else { const float m0 = __uint_as_float(cmax[nn]); iv0 = m0 > 0.f ? QMAX / m0 : 0.f; }
            if (F.tid < 64) scl[n0 + F.tid] = __uint_as_float(cmax[F.tid]) * (1.0f / QMAX); }
        float pm0 = 0.f, pm1 = 0.f, pm2 = 0.f, pm3 = 0.f;
#pragma unroll 1
        for (int k0 = 0; k0 < KTOT; k0 += 256) {
            if (MAPID >= 2) {
                f32x4 v[8];
#pragma unroll
                for (int i = 0; i < 8; ++i) v[i] = *(const f32x4*)(srcv + (size_t)(k0 + kr + 32 * i) * Nsrc + colv);
                if (!sweep) {
#pragma unroll
                    for (int i = 0; i < 8; ++i) { pm0 = fmaxf(pm0, fabsf(v[i][0])); pm1 = fmaxf(pm1, fabsf(v[i][1])); pm2 = fmaxf(pm2, fabsf(v[i][2])); pm3 = fmaxf(pm3, fabsf(v[i][3])); }
                } else {
#pragma unroll
                    for (int i = 0; i < 8; ++i) { const int kk = kr + 32 * i; tile[kk * 65 + 4 * c4 + 0] = v[i][0] * iv0; tile[kk * 65 + 4 * c4 + 1] = v[i][1] * iv1; tile[kk * 65 + 4 * c4 + 2] = v[i][2] * iv2; tile[kk * 65 + 4 * c4 + 3] = v[i][3] * iv3; }
                }
            } else {
                float v[32];
#pragma unroll
                for (int i = 0; i < 32; ++i) v[i] = cols >= 0 ? src0[(size_t)(k0 + kq + 8 * i) * Nsrc + cols] : 0.f;
                if (!sweep) {
#pragma unroll
                    for (int i = 0; i < 32; ++i) pm0 = fmaxf(pm0, fabsf(v[i]));
                } else {
#pragma unroll
                    for (int i = 0; i < 32; ++i) tile[(kq + 8 * i) * 65 + nn] = v[i] * iv0;
                }
            }
            if (sweep) {
                __syncthreads();
                { const int n = F.tid >> 3, kc = F.tid & 7;
#pragma unroll
                  for (int i = 0; i < 2; ++i) { const int k16 = (kc + 8 * i) * 16; unsigned w[4];
#pragma unroll
                      for (int j = 0; j < 4; ++j) { f32x4 q; q[0] = tile[(k16 + 4 * j) * 65 + n]; q[1] = tile[(k16 + 4 * j + 1) * 65 + n]; q[2] = tile[(k16 + 4 * j + 2) * 65 + n]; q[3] = tile[(k16 + 4 * j + 3) * 65 + n];
                          if (FMT == 0) { q[0] = rintf(q[0]); q[1] = rintf(q[1]); q[2] = rintf(q[2]); q[3] = rintf(q[3]); w[j] = pack_i8x4(q); }
                          else { int t = __builtin_amdgcn_cvt_pk_fp8_f32(q[0], q[1], 0, false); t = __builtin_amdgcn_cvt_pk_fp8_f32(q[2], q[3], t, true); w[j] = (unsigned)t; } }
                      *(u32x4*)(dst + (size_t)(n0 + n) * KTOT + k0 + k16) = (u32x4){w[0], w[1], w[2], w[3]}; } }
                __syncthreads();
            }
        }
        if (!sweep) {
            if (MAPID >= 2) { atomicMax((unsigned*)cmax + 4 * c4, __float_as_uint(pm0)); atomicMax((unsigned*)cmax + 4 * c4 + 1, __float_as_uint(pm1)); atomicMax((unsigned*)cmax + 4 * c4 + 2, __float_as_uint(pm2)); atomicMax((unsigned*)cmax + 4 * c4 + 3, __float_as_uint(pm3)); }
            else atomicMax((unsigned*)cmax + nn, __float_as_uint(pm0));
            __syncthreads();
        }
    }
    __syncthreads();
}
__device__ __forceinline__ void convert_unit_gu32(const Frame& F, LAS float* tile, const float* src0, const float* src1, signed char* dst, float* scl, int n0) {
    LAS unsigned* cmax = (LAS unsigned*)(tile + 1024 * 33);
    if (F.tid < 32) cmax[F.tid] = 0u;
    __syncthreads();
    const int c4 = F.tid & 7, kr = F.tid >> 3;
    const int col = map_gu(n0); const float* srcv = ((col & (1 << 30)) ? src1 : src0) + (col & ~(1 << 30)) + 4 * c4;
    float pm0 = 0.f, pm1 = 0.f, pm2 = 0.f, pm3 = 0.f;
#pragma unroll 1
    for (int half = 0; half < 2; ++half) {
        f32x4 v[8];
#pragma unroll
        for (int i = 0; i < 8; ++i) v[i] = *(const f32x4*)(srcv + (size_t)(half * 512 + kr + 64 * i) * FF);
#pragma unroll
        for (int i = 0; i < 8; ++i) { const int k = half * 512 + kr + 64 * i; tile[k * 33 + 4 * c4 + 0] = v[i][0]; tile[k * 33 + 4 * c4 + 1] = v[i][1]; tile[k * 33 + 4 * c4 + 2] = v[i][2]; tile[k * 33 + 4 * c4 + 3] = v[i][3];
            pm0 = fmaxf(pm0, fabsf(v[i][0])); pm1 = fmaxf(pm1, fabsf(v[i][1])); pm2 = fmaxf(pm2, fabsf(v[i][2])); pm3 = fmaxf(pm3, fabsf(v[i][3])); }
    }
    atomicMax((unsigned*)cmax + 4 * c4, __float_as_uint(pm0)); atomicMax((unsigned*)cmax + 4 * c4 + 1, __float_as_uint(pm1)); atomicMax((unsigned*)cmax + 4 * c4 + 2, __float_as_uint(pm2)); atomicMax((unsigned*)cmax + 4 * c4 + 3, __float_as_uint(pm3));
    __syncthreads();
    if (F.tid < 32) scl[n0 + F.tid] = __uint_as_float(cmax[F.tid]) * (1.0f / 127.0f);
    { const int n = F.tid & 31, kc0 = F.tid >> 5; const float m = __uint_as_float(cmax[n]); const float iv = m > 0.f ? 127.0f / m : 0.f;
#pragma unroll
      for (int i = 0; i < 4; ++i) { const int k16 = (kc0 + 16 * i) * 16; unsigned w[4];
#pragma unroll
          for (int j = 0; j < 4; ++j) { f32x4 q; q[0] = rintf(tile[(k16 + 4 * j) * 33 + n] * iv); q[1] = rintf(tile[(k16 + 4 * j + 1) * 33 + n] * iv); q[2] = rintf(tile[(k16 + 4 * j + 2) * 33 + n] * iv); q[3] = rintf(tile[(k16 + 4 * j + 3) * 33 + n] * iv); w[j] = pack_i8x4(q); }
          *(u32x4*)(dst + (size_t)(n0 + n) * 1024 + k16) = (u32x4){w[0], w[1], w[2], w[3]}; } }
    __syncthreads();
}
__device__ __forceinline__ void convert_moe_layer(const Frame& F, LAS unsigned char* lds, int mi) {
    LAS float* tile = (LAS float*)lds;
    constexpr int TGU = 5632 / 32;
    for (int u = F.bid; u < NE * TGU; u += F.G) {
        const int e = u / TGU, r = u % TGU; const size_t so = ((size_t)mi * NE + e) * 1024 * FF;
        convert_unit_gu32(F, tile, F.in[36] + so, F.in[37] + so, WSP(signed char, WS_MGU) + (size_t)e * 5632 * 1024, WSP(float, WS_MGUS) + e * 5632, r * 32);
    }
    for (int u = F.bid; u < NE * 16; u += F.G) {
        const int e = u >> 4, r2 = u & 15; const size_t so = ((size_t)mi * NE + e) * 1024 * FF;
        convert_unit_i8<3, 1, FF>(F, tile, F.in[38] + so, nullptr, 1024, WSP(signed char, WS_MD) + (size_t)e * 1024 * FF, WSP(float, WS_MDS) + e * 1024, r2 * 64);
    }
}

__device__ __forceinline__ void ph_mods(const Frame& F, LAS unsigned char* lds) {
    LAS float* act = (LAS float*)lds;
    LAS float* part = act + 17 * 1024;
    for (int i = F.tid; i < 17 * 1024; i += 512) { const int r = i >> 10, k = i & 1023; const float v = r < 16 ? F.in[1][r * 1024 + k] : F.in[3][k]; act[i] = silu(v); }
    __syncthreads();
    for (int u = F.bid; u < 4 * 48; u += F.G) {
        const int l = u / 48, n0 = (u % 48) * 128, nl = F.tid & 63, kq = F.tid >> 6;
        const float* w = F.in[4] + (size_t)l * 1024 * 6144 + n0 + nl;
        float a[17], c[17];
#pragma unroll
        for (int r = 0; r < 17; ++r) { a[r] = 0.f; c[r] = 0.f; }
#pragma unroll 1
        for (int k = kq * 128; k < kq * 128 + 128; k += 8) {
            float wv[8], wu[8];
#pragma unroll
            for (int j = 0; j < 8; ++j) { wv[j] = w[(size_t)(k + j) * 6144]; wu[j] = w[(size_t)(k + j) * 6144 + 64]; }
#pragma unroll
            for (int r = 0; r < 17; ++r) { const f32x4 a0 = *(const LAS f32x4*)(act + r * 1024 + k), a1 = *(const LAS f32x4*)(act + r * 1024 + k + 4);
                a[r] += (a0[0] * wv[0] + a0[1] * wv[1]) + (a0[2] * wv[2] + a0[3] * wv[3]) + (a1[0] * wv[4] + a1[1] * wv[5]) + (a1[2] * wv[6] + a1[3] * wv[7]);
                c[r] += (a0[0] * wu[0] + a0[1] * wu[1]) + (a0[2] * wu[2] + a0[3] * wu[3]) + (a1[0] * wu[4] + a1[1] * wu[5]) + (a1[2] * wu[6] + a1[3] * wu[7]); }
        }
#pragma unroll
        for (int r = 0; r < 17; ++r) { part[(kq * 17 + r) * 128 + nl] = a[r]; part[(kq * 17 + r) * 128 + 64 + nl] = c[r]; }
        __syncthreads();
        for (int i = F.tid; i < 17 * 128; i += 512) { const int r = i >> 7, n = i & 127; float sacc = F.in[5][l * 6144 + n0 + n];
#pragma unroll
            for (int q = 0; q < 8; ++q) sacc += part[(q * 17 + r) * 128 + n];
            WSP(float, WS_MOD)[((size_t)l * 17 + r) * 6144 + n0 + n] = sacc; }
        __syncthreads();
    }
}
__device__ __forceinline__ void ph_tables(const Frame& F) {
    if (F.bid != (F.G > 100 ? 100 : 0)) return;
    float* tda = WSP(float, WS_ROPE_DA); float* tml = WSP(float, WS_ROPE_ML);
    for (int i = F.tid; i < 64 * 12; i += 512) { const int pos = i / 12, f = i % 12; const float inv = fast_exp2(-(float)(2 * f) / 24.0f * 13.287712379549449f); const float ang = (float)pos * inv; tda[2 * i] = fast_cos(ang); tda[2 * i + 1] = fast_sin(ang); }
    for (int i = F.tid; i < 64 * 8; i += 512) { const int pos = i / 8, f = i % 8; const float inv = fast_exp2(-(float)(2 * f) / 16.0f * 13.287712379549449f); const float ang = (float)pos * inv; tml[2 * i] = fast_cos(ang); tml[2 * i + 1] = fast_sin(ang); }
    if (F.tid < 4) { const int l = F.tid; float s1 = 0.f, s2 = 0.f;
        for (int i = 0; i < 48; ++i) { s1 += F.in[7][l * 48 + i] * F.in[8][l * 48 + i]; s2 += F.in[9][l * 48 + i] * F.in[10][l * 48 + i]; }
        WSP(float, WS_LAM)[l] = fast_exp(s1) - fast_exp(s2) + (0.8f - 0.6f * fast_exp(-0.3f * (float)l)); }
}
__device__ __forceinline__ void ph_filters(const Frame& F, LAS unsigned char* lds) {
    LAS float* zf = (LAS float*)lds;
    LAS float* h1 = zf + 8 * 33;
    LAS float* h2 = h1 + 8 * 64;
    LAS float* h3 = h2 + 8 * 64;
    const int NU = 4 * (256 + 32);
    for (int u = F.bid; u < NU; u += F.G) {
        const int l = u / 288, r = u % 288; const int n = r < 256 ? 2048 : 256; const int i0 = (r < 256 ? r : r - 256) * 8;
        if (F.tid < 8 * 33) { const int p = F.tid / 33, k = F.tid % 33; const int i = i0 + p; float v;
            if (k == 0) v = (float)i / (float)(n - 1);
            else { const int band = (k - 1) & 15; const float f = 1e-4f + (float)band * ((15.0f - 1e-4f) / 15.0f); const float w = 6.283185307179586f * (float)i / (float)n;
                   v = k <= 16 ? fast_cos(f * w) : -fast_sin(f * w); }
            zf[F.tid] = v; }
        __syncthreads();
        { const int p = F.tid >> 6, j = F.tid & 63; const float fr = F.in[21][l * 64 + j];
          float s = F.in[15][l * 64 + j]; for (int k = 0; k < 33; ++k) s += zf[p * 33 + k] * F.in[14][(l * 33 + k) * 64 + j];
          h1[p * 64 + j] = fast_sin(fr * s); __syncthreads();
          s = F.in[17][l * 64 + j]; for (int k = 0; k < 64; ++k) s += h1[p * 64 + k] * F.in[16][(l * 64 + k) * 64 + j];
          h2[p * 64 + j] = fast_sin(fr * s); __syncthreads();
          s = F.in[19][l * 64 + j]; for (int k = 0; k < 64; ++k) s += h2[p * 64 + k] * F.in[18][(l * 64 + k) * 64 + j];
          h3[p * 64 + j] = fast_sin(fr * s); __syncthreads(); }
        bf16_t* HF = n == 2048 ? WSP(bf16_t, WS_HF) + (size_t)l * 2 * 256 * 4096 : WSP(bf16_t, WS_HFC) + (size_t)l * 2 * 256 * 512;
#pragma unroll
        for (int cc = 0; cc < 2; ++cc) {
            const int col = F.tid + 512 * cc; float a[8];
#pragma unroll
            for (int p = 0; p < 8; ++p) a[p] = 0.f;
            for (int k = 0; k < 64; ++k) { const float wv = F.in[20][((size_t)l * 64 + k) * 1024 + col];
#pragma unroll
                for (int p = 0; p < 8; ++p) a[p] += h3[p * 64 + k] * wv; }
            const int dir = col >> 9, ord = (col >> 8) & 1, ch = col & 255;
            const float delta = 3.0701134573253944f + (15.350567286626972f - 3.0701134573253944f) * (float)ch / 255.0f;
            bf16_t* row = HF + ((size_t)ord * 256 + ch) * (2 * n);
#pragma unroll
            for (int p = 0; p < 8; ++p) { const int i = i0 + p; const float t = (float)i / (float)(n - 1); a[p] *= (fast_exp(-t * delta) + 0.05f); if (dir == 1 && i == 0) a[p] = 0.f; }
            u32x4 wv; wv.x = cvt_pk_bf16(a[0], a[1]); wv.y = cvt_pk_bf16(a[2], a[3]); wv.z = cvt_pk_bf16(a[4], a[5]); wv.w = cvt_pk_bf16(a[6], a[7]);
            *(u32x4*)(row + dir * n + i0) = wv;
        }
        __syncthreads();
    }
}

__device__ __forceinline__ void load_vec4(f32x4 (&v)[4], const float* p, int lane) {
#pragma unroll
    for (int i = 0; i < 2; ++i)
#pragma unroll
        for (int k = 0; k < 2; ++k) v[2 * i + k] = *(const f32x4*)(p + 8 * lane + 512 * i + 4 * k);
}
__device__ __forceinline__ void load_row_raw(u32x4 (&h)[2], const bf16_t* row, int lane) {
#pragma unroll
    for (int i = 0; i < 2; ++i) h[i] = *(const u32x4*)(row + 8 * lane + 512 * i);
}
__device__ __forceinline__ void unpack_row_f16(f32x4 (&x)[4], const u32x4 (&hh)[2]) {
#pragma unroll
    for (int i = 0; i < 2; ++i) { const u32x4 h = hh[i]; const f32x2 a0 = unpk_f16(h.x), a1 = unpk_f16(h.y), a2 = unpk_f16(h.z), a3 = unpk_f16(h.w);
        x[2 * i] = (f32x4){a0[0], a0[1], a1[0], a1[1]}; x[2 * i + 1] = (f32x4){a2[0], a2[1], a3[0], a3[1]}; }
}
__device__ __forceinline__ void store_row_f16(bf16_t* row, int lane, const f32x4 (&x)[4]) {
#pragma unroll
    for (int i = 0; i < 2; ++i) { u32x4 w; w.x = cvt_pk_f16(x[2 * i][0], x[2 * i][1]); w.y = cvt_pk_f16(x[2 * i][2], x[2 * i][3]); w.z = cvt_pk_f16(x[2 * i + 1][0], x[2 * i + 1][1]); w.w = cvt_pk_f16(x[2 * i + 1][2], x[2 * i + 1][3]);
        *(u32x4*)(row + 8 * lane + 512 * i) = w; }
}
__device__ __forceinline__ void store_hmod(signed char* H, float* HS, size_t R, int lane, const f32x4 (&x)[4], const f32x4 (&msh)[4], const f32x4 (&msc)[4]) {
    f32x4 h[4]; float am = 0.f;
#pragma unroll
    for (int i = 0; i < 4; ++i) { const f32x4 sh = msh[i], sc = msc[i];
        h[i] = x[i] * (sc + 1.0f) + sh; am = fmaxf(am, fmaxf(fmaxf(fabsf(h[i][0]), fabsf(h[i][1])), fmaxf(fabsf(h[i][2]), fabsf(h[i][3])))); }
    am = wave_max_nonneg(am);
    const float inv = am > 0.f ? 127.0f / am : 0.f;
#pragma unroll
    for (int i = 0; i < 2; ++i) { u32x2 w;
#pragma unroll
        for (int k = 0; k < 2; ++k) { const f32x4 hh = h[2 * i + k]; f32x4 q; q[0] = rintf(hh[0] * inv); q[1] = rintf(hh[1] * inv); q[2] = rintf(hh[2] * inv); q[3] = rintf(hh[3] * inv); if (k == 0) w.x = pack_i8x4(q); else w.y = pack_i8x4(q); }
        *(u32x2*)(H + R * 1024 + 8 * lane + 512 * i) = w; }
    if (lane == 0) HS[R] = am * (1.0f / 127.0f);
}
__device__ __forceinline__ void layer_norm_row(f32x4 (&x)[4], int lane, const f32x4 (&g)[4], const f32x4 (&b)[4]) {
    float s = 0.f;
#pragma unroll
    for (int i = 0; i < 4; ++i) s += (x[i][0] + x[i][1]) + (x[i][2] + x[i][3]);
    const float mu = wave_sum(s, lane) * (1.0f / 1024.0f); float q = 0.f;
#pragma unroll
    for (int i = 0; i < 4; ++i) { const f32x4 d = x[i] - mu; q += (d[0] * d[0] + d[1] * d[1]) + (d[2] * d[2] + d[3] * d[3]); }
    const float rstd = __builtin_amdgcn_rsqf(wave_sum(q, lane) * (1.0f / 1024.0f) + LN_EPS);
#pragma unroll
    for (int i = 0; i < 4; ++i) x[i] = (x[i] - mu) * rstd * g[i] + b[i];
}
__device__ __forceinline__ void ph_init(const Frame& F) {
    signed char* H = WSP(signed char, WS_HMOD); float* HS = WSP(float, WS_HSC); const float* mod = WSP(float, WS_MOD);
    const int rpw = (MR + F.G * 8 - 1) / (F.G * 8); const int R0 = (F.bid * 8 + F.wid) * rpw; int key = -1; f32x4 msh[4], msc[4];
    for (int R = R0; R < R0 + rpw && R < MR; ++R) {
        const int b = R / TPB, j = R % TPB; const float* src = j < CTXL ? F.in[2] + ((size_t)b * CTXL + j) * 1024 : F.in[0] + ((size_t)b * SEQ + (j - CTXL)) * 1024;
        const float* mr = mod + (size_t)(j < CTXL ? 16 : b) * 6144;
        f32x4 x[4];
#pragma unroll
        for (int i = 0; i < 4; ++i) x[i] = *(const f32x4*)(src + 8 * F.lane + 512 * (i >> 1) + 4 * (i & 1));
        { const int k2 = j < CTXL ? 16 : b; if (k2 != key) { key = k2; load_vec4(msh, mr, F.lane); load_vec4(msc, mr + 1024, F.lane); } }
        store_hmod(H, HS, R, F.lane, x, msh, msc);
    }
}
__device__ __forceinline__ void ph_ln1(const Frame& F, LAS unsigned char* lds, int layer, bool latent_only) {
    const bf16_t* YH = WSP(bf16_t, WS_YH); bf16_t* XH = WSP(bf16_t, WS_XH); signed char* H = WSP(signed char, WS_HMOD); float* HS = WSP(float, WS_HSC); const float* mod = WSP(float, WS_MOD) + (size_t)layer * 17 * 6144;
    const float* g = F.in[28] + layer * 1024; const float* bb = F.in[29] + layer * 1024;
    const bool moe = layer & 1; const int mi = layer >> 1;
    LAS float* rw = (LAS float*)lds;
    LAS unsigned* lcnt = (LAS unsigned*)(lds + 32768);
    LAS int* lrec = (LAS int*)(lds + 32768 + 64);
    LAS unsigned* nrec = (LAS unsigned*)(lds + 32768 + 64 + 160 * 20);
    if (moe) {
        for (int i = F.tid; i < 8 * 1024; i += 512) { const int e = i >> 10, k = i & 1023; rw[i] = F.in[35][((size_t)mi * 1024 + k) * 8 + e]; }
        if (F.tid < 16) lcnt[F.tid] = 0u; if (F.tid == 0) *nrec = 0u;
        __syncthreads();
    }
    const int nrows = latent_only ? NB * SEQ : MR;
    f32x4 gv[4], bv[4], msh[4], msc[4]; load_vec4(gv, g, F.lane); load_vec4(bv, bb, F.lane); int key = -1;
    const int rpw = (nrows + F.G * 8 - 1) / (F.G * 8); const int q0 = (F.bid * 8 + F.wid) * rpw;
    const int qend = q0 + rpw < nrows ? q0 + rpw : nrows;
    u32x4 cur[2] = {{0u, 0u, 0u, 0u}, {0u, 0u, 0u, 0u}};
    if (q0 < qend) { const int R = latent_only ? (q0 / SEQ) * TPB + CTXL + (q0 % SEQ) : q0; load_row_raw(cur, YH + (size_t)R * 1024, F.lane); }
    for (int q = q0; q < qend; ++q) {
        const int R = latent_only ? (q / SEQ) * TPB + CTXL + (q % SEQ) : q;
        u32x4 nx[2] = {cur[0], cur[1]};
        if (q + 1 < qend) { const int Rn = latent_only ? ((q + 1) / SEQ) * TPB + CTXL + ((q + 1) % SEQ) : q + 1; load_row_raw(nx, YH + (size_t)Rn * 1024, F.lane); }
        __builtin_amdgcn_sched_barrier(0);
        const int b = R / TPB, j = R % TPB; const float* mr = mod + (size_t)(j < CTXL ? 16 : b) * 6144;
        { const int k2 = j < CTXL ? 16 : b; if (k2 != key) { key = k2; load_vec4(msh, mr + 3 * 1024, F.lane); load_vec4(msc, mr + 4 * 1024, F.lane); } }
        f32x4 x[4];
        unpack_row_f16(x, cur); cur[0] = nx[0]; cur[1] = nx[1];
        layer_norm_row(x, F.lane, gv, bv);
        if (!moe) store_row_f16(XH + (size_t)R * 1024, F.lane, x);
        store_hmod(H, HS, R, F.lane, x, msh, msc);
        if (moe) {
            float lg[8];
#pragma unroll
            for (int e = 0; e < 8; ++e) lg[e] = 0.f;
#pragma unroll
            for (int i = 0; i < 4; ++i) { const int c = 8 * F.lane + 512 * (i >> 1) + 4 * (i & 1); const f32x4 sh = msh[i], sc = msc[i];
                const f32x4 h = x[i] * (sc + 1.0f) + sh;
#pragma unroll
                for (int e = 0; e < 8; ++e) { const f32x4 w = *(const LAS f32x4*)(rw + e * 1024 + c); lg[e] += (h[0] * w[0] + h[1] * w[1]) + (h[2] * w[2] + h[3] * w[3]); } }
#pragma unroll
            for (int e = 0; e < 8; ++e) lg[e] = wave_sum(lg[e], F.lane);
            if (F.lane == 0) {
                int e0 = 0; float l0 = lg[0];
#pragma unroll
                for (int e = 1; e < 8; ++e) if (lg[e] > l0) { l0 = lg[e]; e0 = e; }
                int e1 = -1; float l1 = -3.0e38f;
#pragma unroll
                for (int e = 0; e < 8; ++e) if (e != e0 && lg[e] > l1) { l1 = lg[e]; e1 = e; }
                const float g1 = 1.0f / (1.0f + fast_exp(l0 - l1)); const float g0 = 1.0f - g1;
                WSP(f32x2, WS_MGATE)[R] = (f32x2){g0, g1};
                const unsigned s0 = atomicAdd((unsigned*)lcnt + e0, 1u), s1 = atomicAdd((unsigned*)lcnt + e1, 1u);
                const unsigned ri = atomicAdd((unsigned*)nrec, 1u);
                lrec[ri * 5 + 0] = R; lrec[ri * 5 + 1] = e0; lrec[ri * 5 + 2] = e1; lrec[ri * 5 + 3] = (int)s0; lrec[ri * 5 + 4] = (int)s1;
            }
        }
    }
    if (moe) {
        __syncthreads();
        if (F.tid < 8) lcnt[8 + F.tid] = lcnt[F.tid] ? __hip_atomic_fetch_add(F.ctl + CW_MCNT + (mi * 8 + F.tid) * 64, lcnt[F.tid], __ATOMIC_RELAXED, __HIP_MEMORY_SCOPE_AGENT) : 0u;
        __syncthreads();
        const unsigned nr = *nrec;
        for (unsigned i = F.tid; i < nr; i += 512) { const int R = lrec[i * 5], e0 = lrec[i * 5 + 1], e1 = lrec[i * 5 + 2];
            int4 v; v.x = e0; v.y = e1; v.z = (int)lcnt[8 + e0] + lrec[i * 5 + 3]; v.w = (int)lcnt[8 + e1] + lrec[i * 5 + 4]; WSP(int4, WS_MASG)[R] = v; }
    }
}
__device__ __forceinline__ void ph_gather(const Frame& F, LAS unsigned char* lds, int layer, bool latent_only) {
    const int mi = layer >> 1; LAS int* ps = (LAS int*)lds;
    if (F.tid == 0) { int acc = 0; for (int e = 0; e < 8; ++e) { const int c = (int)__hip_atomic_load(F.ctl + CW_MCNT + (mi * 8 + e) * 64, __ATOMIC_RELAXED, __HIP_MEMORY_SCOPE_AGENT); ps[e] = acc; ps[8 + e] = c; acc += (c + 255) / 256 * 256; } ps[16] = acc; }
    __syncthreads();
    unsigned* mt = F.ctl + CW_MTILE + mi * 512;
    if (F.bid == 0) { const int nt = ps[16] / 256; if (F.tid == 0) mt[0] = (unsigned)nt;
        for (int t = F.tid; t < nt; t += 512) { int e = 0;
#pragma unroll
            for (int k = 1; k < 8; ++k) if (t * 256 >= ps[k]) e = k;
            mt[1 + t] = (unsigned)e; } }
    signed char* rows = WSP(signed char, WS_ROWS8); const signed char* H = WSP(signed char, WS_HMOD); float* rsc = WSP(float, WS_RSC); const float* HS = WSP(float, WS_HSC);
    const int nrows = latent_only ? NB * SEQ : MR;
    for (int q0 = (F.bid * 8 + F.wid) * 4; q0 < nrows; q0 += F.G * 8 * 4) {
        int Rv[4]; int4 av[4]; u32x4 vv[4]; float sv[4];
#pragma unroll
        for (int t = 0; t < 4; ++t) { const int q = q0 + t; Rv[t] = latent_only ? (q / SEQ) * TPB + CTXL + (q % SEQ) : q; av[t] = WSP(int4, WS_MASG)[Rv[t]]; vv[t] = *(const u32x4*)(H + (size_t)Rv[t] * 1024 + F.lane * 16); sv[t] = HS[Rv[t]]; }
#pragma unroll
        for (int t = 0; t < 4; ++t) { int4 a = av[t]; const int d0 = ps[a.x] + a.z, d1 = ps[a.y] + a.w;
            *(u32x4*)(rows + (size_t)d0 * 1024 + F.lane * 16) = vv[t]; *(u32x4*)(rows + (size_t)d1 * 1024 + F.lane * 16) = vv[t];
            if (F.lane == 0) { a.z = d0; a.w = d1; WSP(int4, WS_MASG)[Rv[t]] = a; rsc[d0] = sv[t]; rsc[d1] = sv[t]; } }
    }
    for (int q = F.bid * 8 + F.wid; q < 8 * 256; q += F.G * 8) { const int e = q >> 8, r = q & 255; const int c = ps[8 + e]; const int pc = (c + 255) / 256 * 256;
        if (c + r < pc) { const size_t d = (size_t)(ps[e] + c + r); unsigned zz = 0u; asm volatile("" : "+v"(zz)); const u32x4 z = {zz, zz, zz, zz}; *(u32x4*)(rows + d * 1024 + F.lane * 16) = z; if (F.lane == 0) rsc[d] = 0.f; } }
}
__device__ __forceinline__ void ph_ln2(const Frame& F, int layer, bool latent_only) {
    const bf16_t* YH = WSP(bf16_t, WS_YH); bf16_t* XH = WSP(bf16_t, WS_XH); signed char* H = WSP(signed char, WS_HMOD); float* HS = WSP(float, WS_HSC); const float* mod = WSP(float, WS_MOD) + (size_t)layer * 17 * 6144;
    const float* g = F.in[30] + layer * 1024; const float* bb = F.in[31] + layer * 1024;
    const bool moe = layer & 1; const bf16_t* OE = WSP(bf16_t, WS_ROWS);
    const int nrows = latent_only ? NB * SEQ : MR;
    f32x4 gv[4], bv[4], msh[4], msc[4], g2v[4]; load_vec4(gv, g, F.lane); load_vec4(bv, bb, F.lane); int key = -1;
    const int rpw = (nrows + F.G * 8 - 1) / (F.G * 8); const int q0 = (F.bid * 8 + F.wid) * rpw;
    const int qend = q0 + rpw < nrows ? q0 + rpw : nrows;
    const bf16_t* SRC = YH;
    f32x4 g1v[4], b1v[4]; if (moe) { load_vec4(g1v, F.in[28] + layer * 1024, F.lane); load_vec4(b1v, F.in[29] + layer * 1024, F.lane); }
    u32x4 cur[2] = {{0u, 0u, 0u, 0u}, {0u, 0u, 0u, 0u}}; int4 a = {0, 0, 0, 0}; f32x2 gt = {0.f, 0.f};
    if (q0 < qend) { const int R = latent_only ? (q0 / SEQ) * TPB + CTXL + (q0 % SEQ) : q0; load_row_raw(cur, SRC + (size_t)R * 1024, F.lane); if (moe) { a = WSP(int4, WS_MASG)[R]; gt = WSP(f32x2, WS_MGATE)[R]; } }
    for (int q = q0; q < qend; ++q) {
        const int R = latent_only ? (q / SEQ) * TPB + CTXL + (q % SEQ) : q;
        u32x4 oe[2][2] = {{{0u, 0u, 0u, 0u}, {0u, 0u, 0u, 0u}}, {{0u, 0u, 0u, 0u}, {0u, 0u, 0u, 0u}}};
        if (moe) {
#pragma unroll
            for (int i = 0; i < 2; ++i) { const int c = 8 * F.lane + 512 * i; oe[i][0] = *(const u32x4*)(OE + (size_t)a.z * 1024 + c); oe[i][1] = *(const u32x4*)(OE + (size_t)a.w * 1024 + c); } }
        u32x4 nx[2] = {cur[0], cur[1]}; int4 an = a; f32x2 gn = gt;
        if (q + 1 < qend) { const int Rn = latent_only ? ((q + 1) / SEQ) * TPB + CTXL + ((q + 1) % SEQ) : q + 1; load_row_raw(nx, SRC + (size_t)Rn * 1024, F.lane); if (moe) { an = WSP(int4, WS_MASG)[Rn]; gn = WSP(f32x2, WS_MGATE)[Rn]; } }
        __builtin_amdgcn_sched_barrier(0);
        const int b = R / TPB, j = R % TPB; const float* mr = mod + (size_t)(j < CTXL ? 16 : b) * 6144;
        { const int k2 = j < CTXL ? 16 : b; if (k2 != key) { key = k2; if (moe) load_vec4(g2v, mr + 5 * 1024, F.lane);
            if (layer != DEPTH - 1) { load_vec4(msh, mr + 17 * 6144, F.lane); load_vec4(msc, mr + 17 * 6144 + 1024, F.lane); } } }
        f32x4 x[4];
        unpack_row_f16(x, cur); cur[0] = nx[0]; cur[1] = nx[1];
        if (moe) {
            layer_norm_row(x, F.lane, g1v, b1v);
            const f32x2 gtc = gt; a = an; gt = gn;
#pragma unroll
            for (int i = 0; i < 2; ++i) {
                const u32x4 o0 = oe[i][0], o1 = oe[i][1];
                f32x4 f; f[0] = gtc[0] * bflo(o0.x) + gtc[1] * bflo(o1.x); f[1] = gtc[0] * bfhi(o0.x) + gtc[1] * bfhi(o1.x); f[2] = gtc[0] * bflo(o0.y) + gtc[1] * bflo(o1.y); f[3] = gtc[0] * bfhi(o0.y) + gtc[1] * bfhi(o1.y);
                x[2 * i] = x[2 * i] * ALPHA + g2v[2 * i] * f;
                f[0] = gtc[0] * bflo(o0.z) + gtc[1] * bflo(o1.z); f[1] = gtc[0] * bfhi(o0.z) + gtc[1] * bfhi(o1.z); f[2] = gtc[0] * bflo(o0.w) + gtc[1] * bflo(o1.w); f[3] = gtc[0] * bfhi(o0.w) + gtc[1] * bfhi(o1.w);
                x[2 * i + 1] = x[2 * i + 1] * ALPHA + g2v[2 * i + 1] * f; }
        }
        layer_norm_row(x, F.lane, gv, bv);
        if (layer == DEPTH - 1) {
            float* o = F.out + ((size_t)b * SEQ + (j - CTXL)) * 1024;
#pragma unroll
            for (int i = 0; i < 4; ++i) *(f32x4*)(o + 8 * F.lane + 512 * (i >> 1) + 4 * (i & 1)) = x[i];
        } else {
            store_row_f16(XH + (size_t)R * 1024, F.lane, x);
            store_hmod(H, HS, R, F.lane, x, msh, msc);
        }
    }
}

__device__ __forceinline__ void ph_post(const Frame& F, LAS unsigned char* lds, int layer, bool need_ctx) {
    const bf16_t* P = WSP(bf16_t, WS_PROJ); bf16_t* CQ = WSP(bf16_t, WS_CQN); bf16_t* CKV = WSP(bf16_t, WS_CKVN);
    for (int R0 = (F.bid * 8 + F.wid) * 4; R0 < MR; R0 += F.G * 8 * 4) {
        u32x2 av[4]; unsigned kv[4];
#pragma unroll
        for (int q = 0; q < 4; ++q) { const size_t R = (size_t)(R0 + q); av[q] = *(const u32x2*)(P + R * PLD + C_CQ + 4 * F.lane); kv[q] = *(const unsigned*)(P + R * PLD + C_CKV + 2 * F.lane); }
#pragma unroll
        for (int q = 0; q < 4; ++q) { const size_t R = (size_t)(R0 + q);
            const float a0 = bflo(av[q].x), a1 = bfhi(av[q].x), a2 = bflo(av[q].y), a3 = bfhi(av[q].y);
            const float rs = __builtin_amdgcn_rsqf(wave_sum((a0 * a0 + a1 * a1) + (a2 * a2 + a3 * a3), F.lane) * (1.0f / 256.0f) + RMS_EPS);
            u32x2 w; w.x = cvt_pk_bf16(a0 * rs, a1 * rs); w.y = cvt_pk_bf16(a2 * rs, a3 * rs); *(u32x2*)(CQ + R * 256 + 4 * F.lane) = w;
            const float k0 = bflo(kv[q]), k1 = bfhi(kv[q]);
            const float rk = __builtin_amdgcn_rsqf(wave_sum(k0 * k0 + k1 * k1, F.lane) * (1.0f / 128.0f) + RMS_EPS);
            *(unsigned*)(CKV + R * 256 + 2 * F.lane) = cvt_pk_bf16(k0 * rk, k1 * rk);
            *(unsigned*)(CKV + R * 256 + 128 + 2 * F.lane) = 0u; }
    }
}
__device__ __forceinline__ void ph_conv(LAS unsigned char* lds, int layer, bool need_ctx) {
    const Frame F = make_frame(); const bf16_t* P = WSP(bf16_t, WS_PROJ);
    LAS bf16_t* pt = (LAS bf16_t*)lds;
    LAS bf16_t* ot = (LAS bf16_t*)(lds + 66 * 256 * 2);
    const int NUL = 16 * 32 * 3, NUC = need_ctx ? 16 * 4 * 3 : 0;
#define CONV_LOAD(uq, dstv) do { const bool isc_ = (uq) >= NUL; const int uu_ = isc_ ? (uq) - NUL : (uq); const int n_ = isc_ ? CTXL : SEQ; const int ntt_ = n_ / 64; \
        const int cc_ = uu_ % 3, tt_ = (uu_ / 3) % ntt_, b_ = uu_ / (3 * ntt_); const size_t rb_ = (size_t)b_ * TPB + (isc_ ? 0 : CTXL); \
        _Pragma("unroll") for (int i = 0; i < 5; ++i) { const int id = F.tid + 512 * i; dstv[i] = (u32x4){0u, 0u, 0u, 0u}; if (id < 66 * 32) { const int rr = id >> 5, ch = id & 31; const int t = tt_ * 64 - 1 + rr; \
            if (t >= 0 && t < n_) dstv[i] = *(const u32x4*)(P + (rb_ + t) * PLD + C_HY + cc_ * 256 + ch * 8); } } } while (0)
    const int NU = NUL + NUC, per_low = NU / 288; const bool low = F.bid < 176 || F.G != 256;
    int u, ustep, uend;
    if (F.G != 256) { u = F.bid; ustep = F.G; uend = NU; }
    else if (low) { u = F.bid * per_low; ustep = 1; uend = u + per_low; }
    else { u = 176 * per_low + (F.bid - 176); ustep = 80; uend = NU; }
    u32x4 pre[5];
    if (u < uend) CONV_LOAD(u, pre);
#pragma unroll 1
    while (u < uend) {
        const int un = u + ustep < uend ? u + ustep : NU;
        const bool isc = u >= NUL; const int uu = isc ? u - NUL : u; const int n = isc ? CTXL : SEQ; const int ntt = n / 64;
        const int cc = uu % 3, tt = (uu / 3) % ntt, b = uu / (3 * ntt); const int t0 = tt * 64, c0 = cc * 256;
#pragma unroll
        for (int i = 0; i < 5; ++i) { const int id = F.tid + 512 * i; if (id < 66 * 32) { const int rr = id >> 5, ch = id & 31; *(LAS u32x4*)(pt + rr * 256 + ch * 8) = pre[i]; } }
        if (un < NUL + NUC) CONV_LOAD(un, pre);
        __syncthreads();
        { const int c = F.tid & 255, th = F.tid >> 8; const float* cw = F.in[12] + (size_t)layer * 3 * 768 + c0 + c;
          const float w0 = cw[0], w1 = cw[768], w2 = cw[1536], bs = F.in[13][layer * 768 + c0 + c];
          float pa = bf2f(pt[(th * 32) * 256 + c]), pb = bf2f(pt[(th * 32 + 1) * 256 + c]);
#pragma unroll
          for (int e = 0; e < 32; e += 2) { const int ta = th * 32 + e; const float pc = bf2f(pt[(ta + 2) * 256 + c]), pd = bf2f(pt[(ta + 3) * 256 + c]);
              const float v0 = w0 * pa + w1 * pb + w2 * pc + bs, v1 = w0 * pb + w1 * pc + w2 * pd + bs;
              *(LAS unsigned*)(ot + c * 72 + ta) = cvt_pk_bf16(v0, v1); pa = pc; pb = pd; } }
        __syncthreads();
#pragma unroll
        for (int i = 0; i < 4; ++i) { const int id = F.tid + 512 * i; const int c = id >> 3, t8 = (id & 7) * 8;
          bf16_t* dst = (isc ? WSP(bf16_t, WS_UTC) : WSP(bf16_t, WS_UT)) + ((size_t)(c0 + c) * 16 + b) * n + t0 + t8;
          *(u32x4*)dst = *(const LAS u32x4*)(ot + c * 72 + t8); }
        __syncthreads();
            u = un;
    }
#undef CONV_LOAD
}
__device__ __forceinline__ void hyt_unit(const Frame& F, LAS unsigned char* lds, const bool isc, const int uu) {
    LAS bf16_t* tt_ = (LAS bf16_t*)lds;
    bf16_t* MIXB = WSP(bf16_t, WS_MIX);
    {
        const int n = isc ? CTXL : SEQ; const int ntt = n / 64; const int b = uu / ntt, t0 = (uu % ntt) * 64;
        const bf16_t* src = isc ? WSP(bf16_t, WS_HYTC) : WSP(bf16_t, WS_HYT);
        { const int c = F.tid & 255, th = F.tid >> 8;
#pragma unroll
          for (int i = 0; i < 4; ++i) { const int tc = th * 4 + i; const u32x4 v = *(const u32x4*)(src + ((size_t)c * 16 + b) * n + t0 + tc * 8);
              tt_[(tc * 8 + 0) * 264 + c] = (bf16_t)(v.x & 0xffff); tt_[(tc * 8 + 1) * 264 + c] = (bf16_t)(v.x >> 16); tt_[(tc * 8 + 2) * 264 + c] = (bf16_t)(v.y & 0xffff); tt_[(tc * 8 + 3) * 264 + c] = (bf16_t)(v.y >> 16);
              tt_[(tc * 8 + 4) * 264 + c] = (bf16_t)(v.z & 0xffff); tt_[(tc * 8 + 5) * 264 + c] = (bf16_t)(v.z >> 16); tt_[(tc * 8 + 6) * 264 + c] = (bf16_t)(v.w & 0xffff); tt_[(tc * 8 + 7) * 264 + c] = (bf16_t)(v.w >> 16); } }
        __syncthreads();
        const size_t rbase = (size_t)b * TPB + (isc ? 0 : CTXL) + t0;
#pragma unroll
        for (int i = 0; i < 4; ++i) { const int id = F.tid + 512 * i; const int ta = id >> 5, c8 = id & 31;
            *(u32x4*)(MIXB + (rbase + ta) * 1024 + 384 + c8 * 8) = *(const LAS u32x4*)(tt_ + ta * 264 + c8 * 8); }
        __syncthreads();
    }
}
__device__ __forceinline__ void wait_count(const Frame& F, unsigned* word, unsigned want) {
    if (F.wid == 0) {
        for (unsigned spins = 0; spins < (1u << 22); ++spins) {
            if ((unsigned)__builtin_amdgcn_readfirstlane((int)__hip_atomic_load(word, __ATOMIC_RELAXED, __HIP_MEMORY_SCOPE_AGENT)) >= want) break;
            __builtin_amdgcn_s_sleep(2);
        }
        __builtin_amdgcn_fence(__ATOMIC_ACQUIRE, "agent");
    }
    __syncthreads();
}

__device__ __forceinline__ u32x4 widen_pair32(u32x2 a, u32x2 b) {
    const auto r0 = __builtin_amdgcn_permlane32_swap(a.x, b.x, false, false); const auto r1 = __builtin_amdgcn_permlane32_swap(a.y, b.y, false, false);
    return (u32x4){r0[0], r1[0], r0[1], r1[1]};
}
template <int MLA>
__device__ __forceinline__ void attn_unit(const Frame& F, LAS unsigned char* lds, int layer, int b, int h, int q0, int nkeys) {
    constexpr int NMAP = MLA ? 1 : 2, NKB = MLA ? 6 : 3, DV = MLA ? 64 : 96, NDV = DV / 32;
    constexpr int KS = 208, VS = MLA ? 144 : 208, BUF = 64 * 208 * 2;
    const float* gsub_all = F.in[11];
    const int lane = F.lane, wid = F.wid, r = lane & 31, hh = lane >> 5;
    const bf16_t* P = WSP(bf16_t, WS_PROJ); const bf16_t* MQ = WSP(bf16_t, WS_MQ); const bf16_t* MKV = WSP(bf16_t, WS_MKV);
    const size_t rowb = (size_t)b * TPB; const size_t qrow = rowb + q0 + wid * 32 + r;
    LAS float* red = (LAS float*)(lds + 2 * BUF);
    constexpr int KSL = 64 * 13, VPR = VS / 16, NINST = (KSL + 64 * VPR) / 64;
    const unsigned char* sg[4]; unsigned sstep[4];
#pragma unroll
    for (int j4 = 0; j4 < 4; ++j4) { const int j = wid + 8 * j4; const int sl = (j < NINST ? j : 0) * 64 + lane; const bf16_t* gp; bool isp;
        if (sl < KSL) { const int key = sl / 13; int cc = sl - key * 13; cc = cc >= 12 ? 0 : cc; const size_t row = rowb + key;
            if (!MLA) { gp = P + row * PLD + C_DAK + h * 96 + cc * 8; isp = true; } else if (cc < 8) { gp = MKV + row * MKVLD + h * 128 + cc * 8; isp = false; } else { gp = P + row * PLD + C_KR + (cc - 8) * 8; isp = true; } }
        else { const int s2 = sl - KSL; const int key = s2 / VPR; int cc = s2 - key * VPR; cc = cc >= VPR - 1 ? 0 : cc; const size_t row = rowb + key;
            if (!MLA) { gp = P + row * PLD + C_DAV + h * 96 + cc * 8; isp = true; } else { gp = MKV + row * MKVLD + h * 128 + 64 + cc * 8; isp = false; } }
        sg[j4] = (const unsigned char*)gp; sstep[j4] = isp ? 64u * PLD * 2u : 64u * MKVLD * 2u; }
#define ATT_STAGE(kt, bufi) do { _Pragma("unroll") for (int j4 = 0; j4 < 4; ++j4) { const int j = wid + 8 * j4; if (j < NINST) \
        __builtin_amdgcn_global_load_lds((const unsigned*)(sg[j4] + (size_t)(kt) * sstep[j4]), (LAS unsigned*)(lds + (bufi) * BUF + j * 1024), 16, 0, 0); } } while (0)
    bf16x8 qf[NMAP][NKB];
#pragma unroll
    for (int mp = 0; mp < NMAP; ++mp)
#pragma unroll
        for (int kb = 0; kb < NKB; ++kb)
            qf[mp][kb] = MLA ? *(const bf16x8*)(MQ + qrow * MQLD + h * 96 + kb * 16 + hh * 8) : *(const bf16x8*)(P + qrow * PLD + C_DAQ + h * 96 + mp * 48 + kb * 16 + hh * 8);
    ATT_STAGE(0, 0);
    unsigned* kmt = F.ctl + CW_KMAX + (((layer * 2 + MLA) * 16 + b) * 8 + h);
    if (F.tid == 0) { red[15] = __uint_as_float(__hip_atomic_load(kmt, __ATOMIC_RELAXED, __HIP_MEMORY_SCOPE_AGENT)); red[14] = 0.f; }
    __syncthreads();
    float kmax = red[15];
    __syncthreads();
    if (kmax == 0.f) {
        float best = 0.f;
        for (int key = F.tid; key < TPB; key += 512) {
            float ss[NMAP];
#pragma unroll
            for (int mp = 0; mp < NMAP; ++mp) ss[mp] = 0.f;
#pragma unroll
            for (int cc = 0; cc < 12; ++cc) {
                const bf16_t* gp; if (!MLA) gp = P + (rowb + key) * PLD + C_DAK + h * 96 + cc * 8; else gp = cc < 8 ? MKV + (rowb + key) * MKVLD + h * 128 + cc * 8 : P + (rowb + key) * PLD + C_KR + (cc - 8) * 8;
                const u32x4 v = *(const u32x4*)gp;
                const float t = (bflo(v.x) * bflo(v.x) + bfhi(v.x) * bfhi(v.x)) + (bflo(v.y) * bflo(v.y) + bfhi(v.y) * bfhi(v.y)) + (bflo(v.z) * bflo(v.z) + bfhi(v.z) * bfhi(v.z)) + (bflo(v.w) * bflo(v.w) + bfhi(v.w) * bfhi(v.w));
                ss[MLA ? 0 : cc / 6] += t;
            }
#pragma unroll
            for (int mp = 0; mp < NMAP; ++mp) best = fmaxf(best, ss[mp]);
        }
        best = fmaxf(best, shfl_x(best, lane, 32)); best = fmaxf(best, shfl_x(best, lane, 16)); best = fmaxf(best, shfl_x(best, lane, 8)); best = fmaxf(best, shfl_x(best, lane, 4)); best = fmaxf(best, shfl_x(best, lane, 2)); best = fmaxf(best, shfl_x(best, lane, 1));
        if (lane == 0) red[wid] = best;
        __syncthreads();
        float bm = red[0];
#pragma unroll
        for (int i = 1; i < 8; ++i) bm = fmaxf(bm, red[i]);
        kmax = fmaxf(__builtin_sqrtf(bm), 1e-20f);
        __syncthreads();
        if (F.tid == 0) __hip_atomic_store(kmt, __float_as_uint(kmax), __ATOMIC_RELAXED, __HIP_MEMORY_SCOPE_AGENT);
    }
    float qn = 0.f;
#pragma unroll
    for (int mp = 0; mp < NMAP; ++mp) { float sq = 0.f;
#pragma unroll
        for (int kb = 0; kb < NKB; ++kb) { const u32x4 v = __builtin_bit_cast(u32x4, qf[mp][kb]);
            sq += (bflo(v.x) * bflo(v.x) + bfhi(v.x) * bfhi(v.x)) + (bflo(v.y) * bflo(v.y) + bfhi(v.y) * bfhi(v.y)) + (bflo(v.z) * bflo(v.z) + bfhi(v.z) * bfhi(v.z)) + (bflo(v.w) * bflo(v.w) + bfhi(v.w) * bfhi(v.w)); }
        sq += shfl_x(sq, lane, 32); qn = fmaxf(qn, sq); }
    float mshift = __builtin_sqrtf(qn) * kmax * 1.0005f + 0.02f;
    const int nkt = nkeys / 64;
    if (mshift > 60.f) red[14] = 1.f;
    __syncthreads();
    const bool exact = red[14] != 0.f;
    __syncthreads();
    if (exact) {
        float mx = -3.0e38f;
        asm volatile("s_waitcnt vmcnt(0)" ::: "memory"); __syncthreads();
#pragma unroll 1
        for (int kt = 0; kt < nkt; ++kt) {
            const int buf = kt & 1;
            if (kt + 1 < nkt) ATT_STAGE(kt + 1, buf ^ 1);
            LAS unsigned char* Kb = lds + buf * BUF;
#pragma unroll
            for (int kb32 = 0; kb32 < 2; ++kb32)
#pragma unroll
                for (int mp = 0; mp < NMAP; ++mp) {
                    f32x16 s0;
#pragma unroll
                    for (int i = 0; i < 16; ++i) s0[i] = 0.f;
#pragma unroll
                    for (int kb = 0; kb < NKB; ++kb) s0 = __builtin_amdgcn_mfma_f32_32x32x16_bf16(*(const LAS bf16x8*)(Kb + (kb32 * 32 + r) * KS + (mp * 48 + kb * 16 + hh * 8) * 2), qf[mp][kb], s0, 0, 0, 0);
#pragma unroll
                    for (int i = 0; i < 16; ++i) mx = fmaxf(mx, s0[i]);
                }
            asm volatile("s_waitcnt vmcnt(0)" ::: "memory");
            __syncthreads();
        }
        mshift = fmaxf(mx, shfl_x(mx, lane, 32));
    }
    f32x16 negm;
#pragma unroll
    for (int i = 0; i < 16; ++i) negm[i] = -mshift;
    f32x16 O[NMAP][NDV]; float lrun[NMAP];
#pragma unroll
    for (int mp = 0; mp < NMAP; ++mp) { lrun[mp] = 0.f;
#pragma unroll
        for (int d = 0; d < NDV; ++d)
#pragma unroll
            for (int i = 0; i < 16; ++i) O[mp][d][i] = 0.f; }
    const int trq = (lane & 15) >> 2, trp = lane & 3, blk = (lane >> 4) & 1;
    const int vro = (4 * hh + trq) * VS + blk * 32 + trp * 8;
    if (exact) ATT_STAGE(0, 0);
    asm volatile("s_waitcnt vmcnt(0)" ::: "memory"); __syncthreads();
#pragma unroll 1
    for (int kt = 0; kt < nkt; ++kt) {
        const int buf = kt & 1;
        if (kt + 1 < nkt) ATT_STAGE(kt + 1, buf ^ 1);
        LAS unsigned char* Kb = lds + buf * BUF; LAS unsigned char* Vb = Kb + 64 * KS;
#define ATT_QK(sv, kb32, mp) do { sv = __builtin_amdgcn_mfma_f32_32x32x16_bf16(*(const LAS bf16x8*)(Kb + ((kb32) * 32 + r) * KS + ((mp) * 48 + hh * 8) * 2), qf[mp][0], negm, 0, 0, 0); \
            _Pragma("unroll") for (int kb = 1; kb < NKB; ++kb) sv = __builtin_amdgcn_mfma_f32_32x32x16_bf16(*(const LAS bf16x8*)(Kb + ((kb32) * 32 + r) * KS + ((mp) * 48 + kb * 16 + hh * 8) * 2), qf[mp][kb], sv, 0, 0, 0); } while (0)
#define ATT_EXP(sv, pfv, mp) do { _Pragma("unroll") for (int i = 0; i < 16; ++i) sv[i] = fast_exp2(sv[i]); \
            { const float t0 = add1(sv[0], sv[1]), t1 = add1(sv[2], sv[3]), t2 = add1(sv[4], sv[5]), t3 = add1(sv[6], sv[7]), t4 = add1(sv[8], sv[9]), t5 = add1(sv[10], sv[11]), t6 = add1(sv[12], sv[13]), t7 = add1(sv[14], sv[15]); \
              lrun[mp] = add1(lrun[mp], add1(add1(add1(t0, t1), add1(t2, t3)), add1(add1(t4, t5), add1(t6, t7)))); } \
            _Pragma("unroll") for (int s = 0; s < 2; ++s) { u32x4 w0; w0.x = cvt_pk_bf16(sv[8 * s + 0], sv[8 * s + 1]); w0.y = cvt_pk_bf16(sv[8 * s + 2], sv[8 * s + 3]); w0.z = cvt_pk_bf16(sv[8 * s + 4], sv[8 * s + 5]); w0.w = cvt_pk_bf16(sv[8 * s + 6], sv[8 * s + 7]); \
                pfv[s] = __builtin_bit_cast(bf16x8, w0); } } while (0)
        if (MLA) {
            f32x16 sa, sb; bf16x8 pa[2], pb[2];
            ATT_QK(sa, 0, 0); ATT_QK(sb, 1, 0);
            ATT_EXP(sa, pa, 0);
#pragma unroll
            for (int d = 0; d < NDV; ++d)
#pragma unroll
                for (int s = 0; s < 2; ++s) { LAS unsigned char* vp = Vb + (16 * s) * VS + d * 64 + vro;
                    const s16x4 t0 = __builtin_amdgcn_ds_read_tr16_b64_v4i16((LAS s16x4*)vp); const s16x4 t1 = __builtin_amdgcn_ds_read_tr16_b64_v4i16((LAS s16x4*)(vp + 8 * VS));
                    O[0][d] = __builtin_amdgcn_mfma_f32_32x32x16_bf16(__builtin_shufflevector(t0, t1, 0, 1, 2, 3, 4, 5, 6, 7), pa[s], O[0][d], 0, 0, 0); }
            ATT_EXP(sb, pb, 0);
#pragma unroll
            for (int d = 0; d < NDV; ++d)
#pragma unroll
                for (int s = 0; s < 2; ++s) { LAS unsigned char* vp = Vb + (32 + 16 * s) * VS + d * 64 + vro;
                    const s16x4 t0 = __builtin_amdgcn_ds_read_tr16_b64_v4i16((LAS s16x4*)vp); const s16x4 t1 = __builtin_amdgcn_ds_read_tr16_b64_v4i16((LAS s16x4*)(vp + 8 * VS));
                    O[0][d] = __builtin_amdgcn_mfma_f32_32x32x16_bf16(__builtin_shufflevector(t0, t1, 0, 1, 2, 3, 4, 5, 6, 7), pb[s], O[0][d], 0, 0, 0); }
        } else {
            f32x16 sa, sb; bf16x8 pf[NMAP][2], pg[NMAP][2];
            ATT_QK(sa, 0, 0); ATT_QK(sb, 0, NMAP - 1);
            ATT_EXP(sa, pf[0], 0); ATT_EXP(sb, pf[NMAP - 1], NMAP - 1);
            ATT_QK(sa, 1, 0); ATT_QK(sb, 1, NMAP - 1);
            __builtin_amdgcn_sched_barrier(0);
#define ATT_PVD(kb32, d, pp) do { _Pragma("unroll") for (int s = 0; s < 2; ++s) { \
                LAS unsigned char* vp = Vb + ((kb32) * 32 + 16 * s) * VS + (d) * 64 + vro; \
                const s16x4 t0 = __builtin_amdgcn_ds_read_tr16_b64_v4i16((LAS s16x4*)vp); const s16x4 t1 = __builtin_amdgcn_ds_read_tr16_b64_v4i16((LAS s16x4*)(vp + 8 * VS)); \
                const bf16x8 av = __builtin_shufflevector(t0, t1, 0, 1, 2, 3, 4, 5, 6, 7); \
                _Pragma("unroll") for (int mp = 0; mp < NMAP; ++mp) O[mp][d] = __builtin_amdgcn_mfma_f32_32x32x16_bf16(av, pp[mp][s], O[mp][d], 0, 0, 0); } } while (0)
            ATT_PVD(0, 0, pf); ATT_EXP(sa, pg[0], 0);
            __builtin_amdgcn_sched_barrier(0);
            ATT_PVD(0, 1, pf); ATT_EXP(sb, pg[NMAP - 1], NMAP - 1);
            __builtin_amdgcn_sched_barrier(0);
            ATT_PVD(0, 2, pf);
            __builtin_amdgcn_sched_barrier(0);
#pragma unroll
            for (int d = 0; d < NDV; ++d) { ATT_PVD(1, d, pg); __builtin_amdgcn_sched_barrier(0); }
#undef ATT_PVD
        }
#undef ATT_QK
#undef ATT_EXP
        asm volatile("s_waitcnt vmcnt(0)" ::: "memory");
        __syncthreads();
    }
#undef ATT_STAGE
    bf16_t* MIXB = WSP(bf16_t, WS_MIX);
    float inv[NMAP];
#pragma unroll
    for (int mp = 0; mp < NMAP; ++mp) { const float lt = lrun[mp] + shfl_x(lrun[mp], lane, 32); inv[mp] = 1.0f / lt; }
    if (!MLA) {
        const float lam = WSP(float, WS_LAM)[layer]; const float li = 0.8f - 0.6f * fast_exp(-0.3f * (float)layer);
        const float c0 = inv[0], c1 = lam * inv[NMAP - 1]; float ss = 0.f;
#pragma unroll
        for (int d = 0; d < NDV; ++d)
#pragma unroll
            for (int i = 0; i < 16; ++i) { const float o = O[0][d][i] * c0 - O[NMAP - 1][d][i] * c1; O[0][d][i] = o; ss += o * o; }
        ss += shfl_x(ss, lane, 32);
        const float rs = __builtin_amdgcn_rsqf(ss * (1.0f / 96.0f) + RMS_EPS) * (1.0f - li);
        const float* gsub = gsub_all + layer * 96;
#pragma unroll
        for (int d = 0; d < NDV; ++d)
#pragma unroll
            for (int rp = 0; rp < 2; ++rp) { u32x2 w[2];
#pragma unroll
                for (int q = 0; q < 2; ++q) { const int rg = 2 * rp + q; const int dv = d * 32 + 8 * rg + 4 * hh; const f32x4 gg = *(const f32x4*)(gsub + dv);
                    w[q].x = cvt_pk_bf16(O[0][d][4 * rg] * rs * gg[0], O[0][d][4 * rg + 1] * rs * gg[1]); w[q].y = cvt_pk_bf16(O[0][d][4 * rg + 2] * rs * gg[2], O[0][d][4 * rg + 3] * rs * gg[3]); }
                *(u32x4*)(MIXB + qrow * 1024 + h * 96 + d * 32 + 16 * rp + 8 * hh) = widen_pair32(w[0], w[1]); }
    } else {
#pragma unroll
        for (int d = 0; d < NDV; ++d)
#pragma unroll
            for (int rp = 0; rp < 2; ++rp) { u32x2 w[2];
#pragma unroll
                for (int q = 0; q < 2; ++q) { const int rg = 2 * rp + q;
                    w[q].x = cvt_pk_bf16(O[0][d][4 * rg] * inv[0], O[0][d][4 * rg + 1] * inv[0]); w[q].y = cvt_pk_bf16(O[0][d][4 * rg + 2] * inv[0], O[0][d][4 * rg + 3] * inv[0]); }
                *(u32x4*)(MIXB + qrow * 1024 + 640 + h * 64 + d * 32 + 16 * rp + 8 * hh) = widen_pair32(w[0], w[1]); }
    }
    __syncthreads();
}

template <int N>
__device__ __forceinline__ void hyena_unit(const Frame& F, LAS unsigned char* lds, int layer, int c) {
    constexpr int TPW = N / 128, NSIG = N / 32, CPS = 4 * N + 16, ZS = 2 * N + 16;
    const float* hy_bias = F.in[22];
    LAS unsigned char* CP = lds; LAS unsigned char* ZT = lds + 8 * CPS;
    const bf16_t* UTb = N == SEQ ? WSP(bf16_t, WS_UT) : WSP(bf16_t, WS_UTC);
    bf16_t* OUT = N == SEQ ? WSP(bf16_t, WS_HYT) : WSP(bf16_t, WS_HYTC);
    const bf16_t* HFb = N == SEQ ? WSP(bf16_t, WS_HF) + (size_t)layer * 2 * 256 * 4096 : WSP(bf16_t, WS_HFC) + (size_t)layer * 2 * 256 * 512;
    const int lane = F.lane, w = F.wid;
    for (int id = F.tid; id < 16 * N / 8; id += 512) { const int b = id / (N / 8), t8 = id % (N / 8);
        *(LAS u32x4*)(ZT + b * ZS + t8 * 16) = *(const u32x4*)(UTb + ((size_t)(2 * 256 + c) * 16 + b) * N + t8 * 8); }
    const int r16 = lane & 15, g = lane >> 4, m = r16 & 7, rq = r16 & 8;
    LAS unsigned char* baseA = CP + m * CPS + 2 * (N + 8 * g - rq - 16 * TPW * w);
    LAS unsigned char* baseB = ZT + r16 * ZS + 16 * g;
#pragma unroll 1
    for (int ord = 0; ord < 2; ++ord) {
        const bf16_t* G = HFb + ((size_t)ord * 256 + c) * (2 * N);
        LAS bf16_t* GS = (LAS bf16_t*)(ZT + 16 * ZS);
        for (int ch = F.tid; ch < 2 * N / 8; ch += 512) { const u32x4 v = *(const u32x4*)(G + 8 * ch);
            if (8 * ch >= N) { if (ch == N / 8) { u32x4 w = v; w.x &= 0xffff0000u; (void)w; } *(LAS u32x4*)(GS + 8 * ch) = v; }
            else { const int x0 = N - 8 * ch;
                GS[x0] = (bf16_t)(v.x & 0xffff); GS[x0 - 1] = (bf16_t)(v.x >> 16); GS[x0 - 2] = (bf16_t)(v.y & 0xffff); GS[x0 - 3] = (bf16_t)(v.y >> 16);
                GS[x0 - 4] = (bf16_t)(v.z & 0xffff); GS[x0 - 5] = (bf16_t)(v.z >> 16); GS[x0 - 6] = (bf16_t)(v.w & 0xffff); GS[x0 - 7] = (bf16_t)(v.w >> 16); } }
        __syncthreads();
        if (F.tid == 0) GS[0] = (bf16_t)0;
        if (F.tid == 1) GS[N] = G[0];
        __syncthreads();
        for (int id = F.tid; id < 2 * N; id += 512) { const int mm = id / (2 * N / 8), ch = id % (2 * N / 8); bf16_t v[8];
#pragma unroll
            for (int j = 0; j < 8; ++j) { const int x = 8 * ch + j - mm; v[j] = x >= 0 ? GS[x] : (bf16_t)0; }
            u32x4 wv; wv.x = v[0] | ((unsigned)v[1] << 16); wv.y = v[2] | ((unsigned)v[3] << 16); wv.z = v[4] | ((unsigned)v[5] << 16); wv.w = v[6] | ((unsigned)v[7] << 16);
            *(LAS u32x4*)(CP + mm * CPS + ch * 16) = wv; }
        __syncthreads();
        f32x4 acc[TPW]; bf16x8 win[TPW];
#pragma unroll
        for (int a = 0; a < TPW; ++a) acc[a] = (f32x4){0.f, 0.f, 0.f, 0.f};
#pragma unroll
        for (int a = 2; a < TPW; ++a) win[a] = *(const LAS bf16x8*)(baseA - 32 * a);
#pragma unroll 1
        for (int s8 = 0; s8 < NSIG / 8; ++s8) {
#pragma unroll
            for (int e = 0; e < 8; ++e) {
                const int sg = s8 * 8 + e;
                win[(0 - 2 * e) & (TPW - 1)] = *(const LAS bf16x8*)(baseA + 64 * sg);
                win[(1 - 2 * e) & (TPW - 1)] = *(const LAS bf16x8*)(baseA + 64 * sg - 32);
                const bf16x8 bfr = *(const LAS bf16x8*)(baseB + 64 * sg);
#pragma unroll
                for (int a = 0; a < TPW; ++a) acc[a] = __builtin_amdgcn_mfma_f32_16x16x32_bf16(win[(a - 2 * e) & (TPW - 1)], bfr, acc[a], 0, 0, 0);
            }
        }
        __syncthreads();
        const float bias = hy_bias[((size_t)layer * 2 + ord) * 256 + c];
        const bf16_t* gatep = UTb + ((size_t)(ord * 256 + c) * 16 + r16) * N;
#pragma unroll
        for (int a = 0; a < TPW; ++a) {
            const int t = 16 * (TPW * w + a) + 4 * g;
            const u32x2 gv = *(const u32x2*)(gatep + t); const u32x2 zv = *(const LAS u32x2*)(ZT + r16 * ZS + t * 2);
            const float y0 = bflo(gv.x) * (acc[a][0] + bias * bflo(zv.x)), y1 = bfhi(gv.x) * (acc[a][1] + bias * bfhi(zv.x));
            const float y2 = bflo(gv.y) * (acc[a][2] + bias * bflo(zv.y)), y3 = bfhi(gv.y) * (acc[a][3] + bias * bfhi(zv.y));
            u32x2 o; o.x = cvt_pk_bf16(y0, y1); o.y = cvt_pk_bf16(y2, y3);
            if (ord == 0) *(LAS u32x2*)(ZT + r16 * ZS + t * 2) = o;
            else __hip_atomic_store((unsigned long long*)(OUT + ((size_t)c * 16 + r16) * N + t), (unsigned long long)o.x | ((unsigned long long)o.y << 32), __ATOMIC_RELAXED, __HIP_MEMORY_SCOPE_AGENT);
        }
        __syncthreads();
    }
    asm volatile("s_waitcnt vmcnt(0)" ::: "memory");
    __syncthreads();
    if (F.tid == 0) __hip_atomic_fetch_add(F.ctl + CW_QUEUE + layer * 256 + (N == SEQ ? 64 : 128), 1u, __ATOMIC_RELAXED, __HIP_MEMORY_SCOPE_AGENT);
}

__device__ __forceinline__ int take_ticket(const Frame& F, volatile LAS int* tk, unsigned* q) {
    if (F.tid == 0) *tk = (int)__hip_atomic_fetch_add(q, 1u, __ATOMIC_RELAXED, __HIP_MEMORY_SCOPE_AGENT);
    __syncthreads(); const int u = *tk; __syncthreads(); return u;
}
__device__ __forceinline__ int take_xcd_ticket(const Frame& F, volatile LAS int* tk, unsigned* qbase, int nper) {
    if (F.tid == 0) { const int x0 = (int)xb_xcc_id() & 7; int res = -1;
        for (int i = 0; i < 8; ++i) { const int x = (x0 + i) & 7; const int t = (int)__hip_atomic_fetch_add(qbase + x * 16, 1u, __ATOMIC_RELAXED, __HIP_MEMORY_SCOPE_AGENT); if (t < nper) { res = x * nper + t; break; } }
        *tk = res; }
    __syncthreads(); const int u = *tk; __syncthreads(); return u;
}
__device__ __forceinline__ void ph_mix(LAS unsigned char* lds, int layer, bool need_ctx) {
#define TAKEX(kind, nper) ({ const Frame Ft = make_frame(); take_xcd_ticket(Ft, (volatile LAS int*)(lds + LDS_MISC + 64), Ft.ctl + CW_XQ + (layer * 2 + (kind)) * 128, (nper)); })
#define TAKE(qoff) ({ const Frame Ft = make_frame(); take_ticket(Ft, (volatile LAS int*)(lds + LDS_MISC + 64), Ft.ctl + CW_QUEUE + layer * 256 + (qoff)); })
#pragma unroll 1
    for (;;) { const int u = TAKE(0); if (u >= 256) break; const Frame F = make_frame(); hyena_unit<SEQ>(F, lds, layer, u); }
    const int pda = 64 + (need_ctx ? 8 : 0);
#pragma unroll 1
    for (;;) { const int u = TAKEX(0, pda); if (u < 0) break; const Frame F = make_frame(); const int x = u / pda, t = u % pda;
        int b, h, q0, nk; if (t < 64) { const int g = x * 8 + (t >> 3); b = g >> 2; h = g & 3; q0 = CTXL + (t & 7) * 256; nk = TPB; } else { const int i = x * 8 + (t - 64); b = i >> 2; h = i & 3; q0 = 0; nk = CTXL; }
        attn_unit<0>(F, lds, layer, b, h, q0, nk); }
    const int pml = 96 + (need_ctx ? 12 : 0);
#pragma unroll 1
    for (;;) { const int u = TAKEX(1, pml); if (u < 0) break; const Frame F = make_frame(); const int x = u / pml, t = u % pml;
        int b, h, q0, nk; if (t < 96) { const int g = x * 12 + (t >> 3); b = g / 6; h = g % 6; q0 = CTXL + (t & 7) * 256; nk = TPB; } else { const int i = x * 12 + (t - 96); b = i / 6; h = i % 6; q0 = 0; nk = CTXL; }
        attn_unit<1>(F, lds, layer, b, h, q0, nk); }
    if (need_ctx) {
#pragma unroll 1
        for (;;) { const int u = TAKE(192); if (u >= 256) break; const Frame F = make_frame(); hyena_unit<CTXL>(F, lds, layer, u); }
    }
    { const Frame F = make_frame(); wait_count(F, F.ctl + CW_QUEUE + layer * 256 + 64, 256u); }
#pragma unroll 1
    for (;;) { const int u = TAKE(96); if (u >= 256) break;
#pragma unroll 1
        for (int k = 0; k < 2; ++k) { const Frame F = make_frame(); hyt_unit(F, lds, false, 2 * u + k); } }
    if (layer & 1) {
        const int mi = layer >> 1; constexpr int TGU = 5632 / 32, ND = NE * 16;
#pragma unroll 1
        for (;;) { const int u = TAKE(224); if (u >= ND + NE * TGU) break; const Frame F = make_frame(); LAS float* tile = (LAS float*)lds;
            if (u < ND) { const int e = u >> 4, r2 = u & 15; const size_t so = ((size_t)mi * NE + e) * 1024 * FF;
                convert_unit_i8<3, 1, FF>(F, tile, F.in[38] + so, nullptr, 1024, WSP(signed char, WS_MD) + (size_t)e * 1024 * FF, WSP(float, WS_MDS) + e * 1024, r2 * 64); }
            else { const int v = u - ND, e = v / TGU, r = v % TGU; const size_t so = ((size_t)mi * NE + e) * 1024 * FF;
                convert_unit_gu32(F, tile, F.in[36] + so, F.in[37] + so, WSP(signed char, WS_MGU) + (size_t)e * 5632 * 1024, WSP(float, WS_MGUS) + e * 5632, r * 32); } }
    }
    if (need_ctx) {
        { const Frame F = make_frame(); wait_count(F, F.ctl + CW_QUEUE + layer * 256 + 128, 256u); }
#pragma unroll 1
        for (;;) { const int u = TAKE(160); if (u >= 64) break; const Frame F = make_frame(); hyt_unit(F, lds, true, u); }
    }
#undef TAKE
#undef TAKEX
}

constexpr int NPH = 2 + 15 * DEPTH;
__host__ __device__ inline bool phase_active(int gp) { if (gp < 2) return true; const int l = (gp - 2) / 15, p = (gp - 2) % 15; return (l & 1) ? (p <= 7 + 2 * MOE_NCH || p == 14) : (p <= 8 || p == 14); }

template <int layer>
__device__ __forceinline__ void layer_phases(LAS unsigned char* lds, const int lo, const int hi) {
#define IN(k) (lo <= (k) && (k) < hi)
#define SEAM(k) do { if ((k) + 1 < hi) xcd_barrier_impl((unsigned*)(kargs()->ws + WS_CTL) + CW_BAR, xb_xcc_id(), (volatile LAS unsigned*)(lds + LDS_MISC)); } while (0)
        const int base = 2 + 15 * layer;
        if (hi <= base || lo >= base + 15) return;
        constexpr bool moe = layer & 1, last = layer == DEPTH - 1, need_ctx = !last;
        constexpr int mi = layer >> 1;

        if (IN(base + 0)) { const Frame F = make_frame();
            pg8::Gemm g{WSP(bf16_t, WS_HMOD), (const bf16_t*)(WSP(signed char, WS_WIN) + (size_t)layer * NINP * 1024), 512};
            pg8::RowOrder S{MR / 256, NINP / 256, F.G, F.bid, 0};
            EpiProj E{WSP(bf16_t, WS_PROJ), WSP(float, WS_ROPE_DA), WSP(float, WS_ROPE_ML), WSP(float, WS_HSC), WSP(float, WS_WINS) + layer * NINP, WSP(float, WS_SS)};
            pg8::gemm_phase<EpiProj, pg8::RowOrder, 1>(lds, g, S, E);
            SEAM(base + 0);
        }
        if (IN(base + 2)) { const Frame F = make_frame();
            { pg8::Gemm g{WSP(bf16_t, WS_PROJ) + C_CQ, WSP(bf16_t, WS_WUQ) + (size_t)layer * 768 * 256, 256, PLD, 0};
              pg8::RowOrder S{MR / 256, 3, F.G, F.bid, 0};
              EpiMlaQ E{WSP(bf16_t, WS_MQ), WSP(float, WS_ROPE_ML), WSP(float, WS_SS)};
              pg8::gemm_phase(lds, g, S, E); }
            __syncthreads();
            { pg8::Gemm g{WSP(bf16_t, WS_PROJ) + C_CKV, WSP(bf16_t, WS_WUKV) + (size_t)layer * 768 * 256, 128, PLD, 256};
              pg8::RowOrder S{MR / 256, 3, F.G, F.bid, 0};
              EpiMlaKV E{WSP(bf16_t, WS_MKV), WSP(float, WS_SS)};
              pg8::gemm_phase(lds, g, S, E); }
            __syncthreads();
            ph_conv(lds, layer, need_ctx);
            SEAM(base + 2);
        }
        if (IN(base + 3)) { const Frame F = make_frame(); ph_mix(lds, layer, need_ctx); SEAM(base + 3); }
        if (IN(base + 5)) { const Frame F = make_frame();
            pg8::Gemm g{WSP(bf16_t, WS_MIX), WSP(bf16_t, WS_WOUT) + (size_t)layer * 1024 * 1024, 1024};
            pg8::RowOrder S{last ? 128 : MR / 256, 4, F.G, F.bid, last ? 1 : 0};
            EpiResid<layer == 0> E{WSP(bf16_t, WS_YH), WSP(bf16_t, WS_XH), WSP(float, WS_MOD) + (size_t)layer * 17 * 6144 + 2 * 1024, nullptr, 1.f};
            pg8::gemm_phase(lds, g, S, E);
            SEAM(base + 5);
        }
        if (IN(base + 6)) { const Frame F = make_frame(); ph_ln1(F, lds, layer, last); SEAM(base + 6); }
        if (!moe) {
            if (IN(base + 7)) { const Frame F = make_frame();
                pg8::Gemm g{WSP(bf16_t, WS_HMOD), (const bf16_t*)(WSP(signed char, WS_WGU) + (size_t)mi * 5632 * 1024), 512};
                pg8::RowOrder S{MR / 256, 22, F.G, F.bid, 0};
                EpiSwiglu E{WSP(unsigned char, WS_HID), WSP(float, WS_HSC), WSP(float, WS_WGUS) + mi * 5632};
                pg8::gemm_phase<EpiSwiglu, pg8::RowOrder, 1>(lds, g, S, E);
                SEAM(base + 7);
            }
            if (IN(base + 8)) { const Frame F = make_frame();
                pg8::Gemm g{WSP(bf16_t, WS_HID), (const bf16_t*)(WSP(signed char, WS_WD) + (size_t)mi * 1024 * FF), FF / 2};
                pg8::RowOrder S{MR / 256, 4, F.G, F.bid, 0};
                EpiResid<false> E{WSP(bf16_t, WS_YH), WSP(bf16_t, WS_XH), WSP(float, WS_MOD) + (size_t)layer * 17 * 6144 + 5 * 1024, WSP(float, WS_WDS) + mi * 1024, 1.0f / HSCL};
                pg8::gemm_phase<EpiResid<false>, pg8::RowOrder, 2>(lds, g, S, E);
                SEAM(base + 8);
            }
        } else {
            if (IN(base + 7)) { const Frame F = make_frame(); ph_gather(F, lds, layer, last); SEAM(base + 7); }
#pragma unroll 1
            for (int ch = 0; ch < MOE_NCH; ++ch) {
                if (IN(base + 8 + 2 * ch)) { const Frame F = make_frame(); const unsigned* mt = F.ctl + CW_MTILE + mi * 512;
                    const int NT = (int)mt[0]; int nM = NT - ch * MOE_CH; nM = nM > MOE_CH ? MOE_CH : nM;
                    pg8::Gemm g{WSP(bf16_t, WS_ROWS8), WSP(bf16_t, WS_MGU), 512};
                    pg8::MoeOrder S{nM, 22, F.G, F.bid, ch * MOE_CH, 0, 1, mt + 1, (size_t)5632 * 1024};
                    EpiSwiglu E{WSP(unsigned char, WS_HIDC), WSP(float, WS_RSC), WSP(float, WS_MGUS)};
                    pg8::gemm_phase<EpiSwiglu, pg8::MoeOrder, 1>(lds, g, S, E);
                    SEAM(base + 8 + 2 * ch);
                }
                if (IN(base + 9 + 2 * ch)) { const Frame F = make_frame(); const unsigned* mt = F.ctl + CW_MTILE + mi * 512;
                    const int NT = (int)mt[0]; int nM = NT - ch * MOE_CH; nM = nM > MOE_CH ? MOE_CH : nM;
                    pg8::Gemm g{WSP(bf16_t, WS_HIDC), WSP(bf16_t, WS_MD), FF / 2};
                    pg8::MoeOrder S{nM, 4, F.G, F.bid, ch * MOE_CH, 1, 0, mt + 1, (size_t)1024 * FF};
                    EpiBf16 E{WSP(bf16_t, WS_ROWS), 1024, WSP(float, WS_MDS), 1.0f / HSCL};
                    pg8::gemm_phase<EpiBf16, pg8::MoeOrder, 2>(lds, g, S, E);
                    SEAM(base + 9 + 2 * ch);
                }
            }
        }
        if (IN(base + 14)) { const Frame F = make_frame(); ph_ln2(F, layer, last); SEAM(base + 14); }
    #undef IN
#undef SEAM
}

__global__ void __launch_bounds__(512, 2) fwd(Args args) {
    extern __shared__ __attribute__((aligned(16))) unsigned char lds_raw[];
    LAS unsigned char* lds = (LAS unsigned char*)lds_raw;
    if (threadIdx.x < 64) ((LAS unsigned*)(lds + LDS_MISC))[threadIdx.x] = 0u;
    __syncthreads();
    XcdBarrier bar; bar.bar = (unsigned*)(args.ws + WS_CTL) + CW_BAR; bar.x = 0; bar.st = (volatile LAS unsigned*)(lds + LDS_MISC);
    if (args.use_bar) bar = xcd_barrier_post((unsigned*)(args.ws + WS_CTL) + CW_BAR, (volatile LAS unsigned*)(lds + LDS_MISC));
    const int lo = args.ph_lo, hi = args.ph_hi; (void)bar;
#define IN(k) (lo <= (k) && (k) < hi)
#define SEAM(k) do { if ((k) + 1 < hi) xcd_barrier_impl((unsigned*)(kargs()->ws + WS_CTL) + CW_BAR, xb_xcc_id(), (volatile LAS unsigned*)(lds + LDS_MISC)); } while (0)

    if (IN(0)) { const Frame F = make_frame();
        ph_mods(F, lds); __syncthreads();
        ph_tables(F);
        ph_filters(F, lds); __syncthreads();
        LAS float* tile = (LAS float*)lds;
        for (int l = 0; l < DEPTH; ++l) {
            { int u0 = F.bid - 37 * (l + 1) % 256; if (u0 < 0) u0 += F.G; for (int u = u0; u < NINP / 64; u += F.G) convert_unit_i8<0>(F, tile, F.in[6] + (size_t)l * 1024 * PLD, nullptr, PLD, WSP(signed char, WS_WIN) + (size_t)l * NINP * 1024, WSP(float, WS_WINS) + l * NINP, u * 64); }
            convert_matrix<3>(F, tile, F.in[27] + (size_t)l * 1024 * 1024, nullptr, 1024, 1024, WSP(bf16_t, WS_WOUT) + (size_t)l * 1024 * 1024, 1024, 1024, nullptr, 74);
            convert_matrix<1>(F, tile, F.in[24] + (size_t)l * 256 * MQLD, nullptr, MQLD, 256, WSP(bf16_t, WS_WUQ) + (size_t)l * 768 * 256, 256, 768, F.in[23] + l * 256, 111);
            convert_matrix<3>(F, tile, F.in[26] + (size_t)l * 128 * 768, nullptr, 768, 128, WSP(bf16_t, WS_WUKV) + (size_t)l * 768 * 256, 256, 768, F.in[25] + l * 128, 148);
        }
        for (int i = 0; i < 2; ++i) {
            { int u0 = F.bid - (101 + 90 * i); if (u0 < 0) u0 += F.G; for (int u = u0; u < 5632 / 32; u += F.G) convert_unit_gu32(F, tile, F.in[32] + (size_t)i * 1024 * FF, F.in[33] + (size_t)i * 1024 * FF, WSP(signed char, WS_WGU) + (size_t)i * 5632 * 1024, WSP(float, WS_WGUS) + i * 5632, u * 32); }
            { int u0 = F.bid - (60 + 30 * i); if (u0 < 0) u0 += F.G; for (int u = u0; u < 16; u += F.G) convert_unit_i8<3, 1, FF>(F, tile, F.in[34] + (size_t)i * FF * 1024, nullptr, 1024, WSP(signed char, WS_WD) + (size_t)i * 1024 * FF, WSP(float, WS_WDS) + i * 1024, u * 64); }
        }
        SEAM(0);
    }
    if (IN(1)) { const Frame F = make_frame(); ph_init(F); SEAM(1); }

    layer_phases<0>(lds, lo, hi);
    layer_phases<1>(lds, lo, hi);
    layer_phases<2>(lds, lo, hi);
    layer_phases<3>(lds, lo, hi);
#undef IN
#undef SEAM
}

extern "C" void kernel_launch(void* const* d_in, const int* in_sizes, int n_in, void* d_out, int out_size, void* d_ws, size_t ws_size, hipStream_t stream) {
    static int grid = 0;
    if (grid == 0) {
        if (n_in != 39 || ws_size < WS_END) { fprintf(stderr, "kernel_launch: need 39 inputs and %zu workspace bytes (got %d, %zu)\n", (size_t)WS_END, n_in, ws_size); grid = -1; return; }
        int dev = 0, cus = 0, per_cu = 0;
        if (hipGetDevice(&dev) != hipSuccess || hipDeviceGetAttribute(&cus, hipDeviceAttributeMultiprocessorCount, dev) != hipSuccess) { grid = -1; return; }
        if (hipFuncSetAttribute((const void*)fwd, hipFuncAttributeMaxDynamicSharedMemorySize, LDS_BYTES) != hipSuccess) { fprintf(stderr, "kernel_launch: hipFuncSetAttribute failed\n"); grid = -1; return; }
        if (hipOccupancyMaxActiveBlocksPerMultiprocessor(&per_cu, (const void*)fwd, 512, LDS_BYTES) != hipSuccess || per_cu < 1) { fprintf(stderr, "kernel_launch: occupancy query reports %d\n", per_cu); (void)hipGetLastError(); }
        grid = cus;
    }
    if (grid < 0) return;
    (void)hipMemsetAsync((char*)d_ws + WS_CTL, 0, CTL_BYTES, stream);
    Args a{};
    for (int i = 0; i < 39; ++i) a.in[i] = (const float*)d_in[i];
    a.out = (float*)d_out; a.ws = (unsigned char*)d_ws; a.pad = 0;
#if MK_SINGLE
    a.ph_lo = 0; a.ph_hi = NPH; a.use_bar = 1;
    hipLaunchKernelGGL(fwd, dim3(grid), dim3(512), LDS_BYTES, stream, a);
#else
    for (int gp = 0; gp < NPH; ++gp) { if (!phase_active(gp)) continue; a.ph_lo = gp; a.ph_hi = gp + 1; a.use_bar = 0;
        hipLaunchKernelGGL(fwd, dim3(grid), dim3(512), LDS_BYTES, stream, a); }
#endif
}
```

```cpp
#include <hip/hip_runtime.h>
#include <cstdio>
#include <cstdint>

#ifndef MK_SINGLE
#define MK_SINGLE 1
#endif

#define LAS __attribute__((address_space(3)))
typedef unsigned short bf16_t;
typedef short bf16x8 __attribute__((ext_vector_type(8)));
typedef short s16x4 __attribute__((ext_vector_type(4)));
typedef float f32x4 __attribute__((ext_vector_type(4)));
typedef float f32x2 __attribute__((ext_vector_type(2)));
typedef float f32x16 __attribute__((ext_vector_type(16)));
typedef unsigned u32x4 __attribute__((ext_vector_type(4)));
typedef unsigned u32x2 __attribute__((ext_vector_type(2)));

constexpr int D = 1024, NB = 16, SEQ = 2048, CTXL = 256, TPB = SEQ + CTXL, MR = NB * TPB, DEPTH = 4;
constexpr int PLD = 2336, NINP = 2560;
constexpr int C_DAQ = 0, C_DAK = 384, C_DAV = 768, C_HY = 1152, C_CQ = 1920, C_CKV = 2176, C_KR = 2304;
constexpr int FF = 2816, NE = 8;
constexpr int MQLD = 576, MKVLD = 768;
constexpr int MOE_MAXT = 296;
constexpr int MOE_CH = 296;
constexpr int MOE_NCH = 1;
constexpr float LN_EPS = 1e-5f, RMS_EPS = 1e-6f;
constexpr float HSCL = 4.0f;
constexpr float ALPHA = 1.6817928305074290f;
constexpr float LOG2E = 1.4426950408889634f;
constexpr float SC_DA = 0.14433756729740643f * LOG2E;
constexpr float SC_ML = 0.10206207261596575f * LOG2E;
constexpr int LDS_BYTES = 147456;
constexpr int LDS_MISC = LDS_BYTES - 1024;

constexpr size_t al(size_t x) { return (x + 255) & ~size_t(255); }
constexpr size_t CTL_BYTES = 65536;
constexpr size_t WS_CTL = 0;
constexpr size_t WS_MOD = WS_CTL + CTL_BYTES;
constexpr size_t WS_ROPE_DA = al(WS_MOD + 4ull * 17 * 6144 * 4);
constexpr size_t WS_ROPE_ML = al(WS_ROPE_DA + 64 * 12 * 8);
constexpr size_t WS_LAM = al(WS_ROPE_ML + 64 * 8 * 8);
constexpr size_t WS_HF = al(WS_LAM + 256);
constexpr size_t WS_HFC = al(WS_HF + 4ull * 2 * 256 * 4096 * 2);
constexpr size_t WS_WIN = al(WS_HFC + 4ull * 2 * 256 * 512 * 2);
constexpr size_t WS_WINS = al(WS_WIN + 4ull * NINP * 1024);
constexpr size_t WS_WOUT = al(WS_WINS + 4ull * NINP * 4);
constexpr size_t WS_WUQ = al(WS_WOUT + 4ull * 1024 * 1024 * 2);
constexpr size_t WS_WUKV = al(WS_WUQ + 4ull * 768 * 256 * 2);
constexpr size_t WS_WGU = al(WS_WUKV + 4ull * 768 * 256 * 2);
constexpr size_t WS_WGUS = al(WS_WGU + 2ull * 5632 * 1024);
constexpr size_t WS_WD = al(WS_WGUS + 2ull * 5632 * 4);
constexpr size_t WS_WDS = al(WS_WD + 2ull * 1024 * 2816);
constexpr size_t WS_MGU = al(WS_WDS + 2ull * 1024 * 4);
constexpr size_t WS_MGUS = al(WS_MGU + 8ull * 5632 * 1024);
constexpr size_t WS_MD = al(WS_MGUS + 8ull * 5632 * 4);
constexpr size_t WS_MDS = al(WS_MD + 8ull * 1024 * 2816);
constexpr size_t WS_X = al(WS_MDS + 8ull * 1024 * 4);
constexpr size_t WS_YH = WS_X, WS_XH = WS_X + (size_t)MR * 1024 * 2;
constexpr size_t WS_HMOD = al(WS_X + (size_t)MR * 1024 * 4);
constexpr size_t WS_HSC = al(WS_HMOD + (size_t)MR * 1024);
constexpr size_t WS_MASG = al(WS_HSC + (size_t)MR * 4);
constexpr size_t WS_MGATE = al(WS_MASG + (size_t)MR * 16);
constexpr size_t WS_R = al(WS_MGATE + (size_t)MR * 8);
constexpr size_t WS_PROJ = WS_R;
constexpr size_t WS_MIX = al(WS_PROJ + (size_t)MR * PLD * 2);
constexpr size_t WS_UT = al(WS_MIX + (size_t)MR * 1024 * 2);
constexpr size_t WS_UTC = al(WS_UT + 768ull * 16 * 2048 * 2);
constexpr size_t WS_HYT = al(WS_UTC + 768ull * 16 * 256 * 2);
constexpr size_t WS_HYTC = al(WS_HYT + 256ull * 16 * 2048 * 2);
constexpr size_t WS_CQN = al(WS_HYTC + 256ull * 16 * 256 * 2);
constexpr size_t WS_CKVN = al(WS_CQN + (size_t)MR * 256 * 2);
constexpr size_t WS_SS = WS_CQN;
constexpr size_t WS_MQ = al(WS_CKVN + (size_t)MR * 256 * 2);
constexpr size_t WS_MKV = al(WS_MQ + (size_t)MR * MQLD * 2);
constexpr size_t WS_END = al(WS_MKV + (size_t)MR * MKVLD * 2);
constexpr size_t WS_HID = WS_R;
constexpr size_t WS_ROWS = WS_R;
constexpr size_t WS_HIDC = al(WS_ROWS + (size_t)MOE_MAXT * 256 * 1024 * 2);
constexpr size_t WS_ROWS8 = al(WS_HIDC + (size_t)MOE_CH * 256 * FF);
constexpr size_t WS_RSC = al(WS_ROWS8 + (size_t)MOE_MAXT * 256 * 1024);
static_assert(WS_HID + (size_t)MR * FF * 2 <= WS_UT, "dense hidden must fit over proj+mix");
static_assert(WS_RSC + (size_t)MOE_MAXT * 256 * 4 <= WS_END, "moe buffers must fit in region");
static_assert(WS_END <= 934000000ull, "workspace budget");

constexpr int CW_BAR = 0;
constexpr int CW_QUEUE = 4096;
constexpr int CW_MCNT = 4096 + 256 * 4;
constexpr int CW_MTILE = 8192;
constexpr int CW_XQ = 12288;
constexpr int CW_KMAX = 10240;

struct Args { const float* in[39]; float* out; unsigned char* ws; int ph_lo, ph_hi, use_bar, pad; };

typedef __bf16 bf16v2_t __attribute__((ext_vector_type(2)));
__device__ __forceinline__ unsigned cvt_pk_bf16(float lo, float hi) { return __builtin_bit_cast(unsigned, __builtin_convertvector((f32x2){lo, hi}, bf16v2_t)); }
typedef _Float16 f16v2_t __attribute__((ext_vector_type(2)));
__device__ __forceinline__ unsigned cvt_pk_f16(float lo, float hi) { lo = __builtin_amdgcn_fmed3f(lo, -65504.0f, 65504.0f); hi = __builtin_amdgcn_fmed3f(hi, -65504.0f, 65504.0f);
    return __builtin_bit_cast(unsigned, __builtin_convertvector((f32x2){lo, hi}, f16v2_t)); }
__device__ __forceinline__ f32x2 unpk_f16(unsigned w) { return __builtin_convertvector(__builtin_bit_cast(f16v2_t, w), f32x2); }
__device__ __forceinline__ float bf2f(bf16_t v) { return __uint_as_float(((unsigned)v) << 16); }
__device__ __forceinline__ float bflo(unsigned v) { return __uint_as_float(v << 16); }
__device__ __forceinline__ float bfhi(unsigned v) { return __uint_as_float(v & 0xffff0000u); }
__device__ __forceinline__ bf16_t f2bf(float f) { return (bf16_t)(cvt_pk_bf16(f, 0.f) & 0xffffu); }
__device__ __forceinline__ float shfl_x(float v, int lane, int mask) { return __int_as_float(__builtin_amdgcn_ds_bpermute((lane ^ mask) << 2, __float_as_int(v))); }
template <int CTRL, int ROWMASK> __device__ __forceinline__ float dpp_f(float v) { return __int_as_float(__builtin_amdgcn_update_dpp(0, __float_as_int(v), CTRL, ROWMASK, 0xf, false)); }
__device__ __forceinline__ float wave_sum(float v, int) {
    v += dpp_f<0xb1, 0xf>(v); v += dpp_f<0x4e, 0xf>(v); v += dpp_f<0x124, 0xf>(v); v += dpp_f<0x128, 0xf>(v);
    v += dpp_f<0x142, 0xa>(v); v += dpp_f<0x143, 0xc>(v);
    return __int_as_float(__builtin_amdgcn_readlane(__float_as_int(v), 63));
}
__device__ __forceinline__ float wave_max_nonneg(float v) {
    v = fmaxf(v, dpp_f<0xb1, 0xf>(v)); v = fmaxf(v, dpp_f<0x4e, 0xf>(v)); v = fmaxf(v, dpp_f<0x124, 0xf>(v)); v = fmaxf(v, dpp_f<0x128, 0xf>(v));
    v = fmaxf(v, dpp_f<0x142, 0xa>(v)); v = fmaxf(v, dpp_f<0x143, 0xc>(v));
    return __int_as_float(__builtin_amdgcn_readlane(__float_as_int(v), 63));
}
__device__ __forceinline__ float fast_exp2(float x) { return __builtin_amdgcn_exp2f(x); }
__device__ __forceinline__ float add1(float a, float b) { float r; asm("v_add_f32 %0, %1, %2" : "=v"(r) : "v"(a), "v"(b)); return r; }
__device__ __forceinline__ float fast_exp(float x) { return __builtin_amdgcn_exp2f(x * LOG2E); }
__device__ __forceinline__ float fast_sin(float x) { float r = x * 0.15915494309189535f; r -= rintf(r); return __builtin_amdgcn_sinf(r); }
__device__ __forceinline__ float fast_cos(float x) { float r = x * 0.15915494309189535f; r -= rintf(r); return __builtin_amdgcn_cosf(r); }
__device__ __forceinline__ float silu(float x) { return x / (1.0f + fast_exp(-x)); }
__device__ __forceinline__ unsigned pack_i8x4(f32x4 q) {
    const int a = (int)q[0], b = (int)q[1], c = (int)q[2], d = (int)q[3];
    return (unsigned)(a & 255) | ((unsigned)(b & 255) << 8) | ((unsigned)(c & 255) << 16) | ((unsigned)d << 24);
}

#define XB_TMO      128
#define XB_XCNT(j)  (256  + 64 * (j))
#define XB_XSUB(j)  (1280 + 64 * (j))
#define XB_XGEN(j)  (2304 + 64 * (j))
#define XB_TOP      3328
#define XB_TOPGEN   3392
#define XCD_BAR_WORDS 3456
#define XB_SPIN_CAP (1u << 22)
__device__ __forceinline__ unsigned xb_ld(unsigned* p)              { return __hip_atomic_load(p, __ATOMIC_RELAXED, __HIP_MEMORY_SCOPE_AGENT); }
__device__ __forceinline__ unsigned xb_add(unsigned* p, unsigned v) { return __hip_atomic_fetch_add(p, v, __ATOMIC_RELAXED, __HIP_MEMORY_SCOPE_AGENT); }
__device__ __forceinline__ unsigned xb_xcc_id() { return (unsigned)__builtin_amdgcn_s_getreg((3 << 11) | 20) & 0xFu; }
#define XB_SPIN(cond, bar) do { unsigned _sp = 0; while (cond) { __builtin_amdgcn_s_sleep(1); \
    if ((++_sp & 255u) == 0u) { if (xb_ld(&(bar)[XB_TMO])) break; if (_sp > XB_SPIN_CAP) { atomicAdd(&(bar)[XB_TMO], 1u); break; } } } } while (0)
struct XcdBarrier { unsigned* bar; unsigned x; volatile LAS unsigned* st; };
__device__ __forceinline__ XcdBarrier xcd_barrier_post(unsigned* bar, volatile LAS unsigned* st) {
    XcdBarrier b; b.bar = bar; b.x = xb_xcc_id(); b.st = st;
    if (threadIdx.x == 0) (void)xb_add(&bar[XB_XCNT(b.x)], 1u);
    return b;
}
__device__ __forceinline__ void xcd_barrier_complete(unsigned* bar, unsigned x, unsigned& nloc, unsigned& nx) {
    const unsigned G = gridDim.x * gridDim.y * gridDim.z;
    unsigned sum, cnt, mine, sp = 0u;
    for (;;) {
        sum = 0u; cnt = 0u; mine = 0u;
#pragma unroll
        for (unsigned j = 0; j < 16; ++j) { const unsigned c = xb_ld(&bar[XB_XCNT(j)]); sum += c; cnt += (c > 0u) ? 1u : 0u; mine = (j == x) ? c : mine; }
        if (sum == G) break;
        __builtin_amdgcn_s_sleep(1);
        if ((++sp & 255u) == 0u) { if (xb_ld(&bar[XB_TMO])) break; if (sp > XB_SPIN_CAP) { atomicAdd(&bar[XB_TMO], 1u); break; } }
    }
    nloc = mine > 0u ? mine : 1u; nx = cnt > 0u ? cnt : 1u;
}
__device__ __forceinline__ void xcd_barrier_impl(unsigned* bar_, unsigned bx, volatile LAS unsigned* st_) {
    XcdBarrier b; b.bar = bar_; b.x = bx; b.st = st_;
    asm volatile("s_waitcnt vmcnt(0)" ::: "memory");
    __syncthreads();
    if (threadIdx.x == 0) {
        unsigned* bar = b.bar;
        __builtin_amdgcn_s_waitcnt(0);
        unsigned nloc = b.st[0], nx = b.st[1];
        if (nloc == 0u) { xcd_barrier_complete(bar, b.x, nloc, nx); b.st[0] = nloc; b.st[1] = nx; }
        const unsigned old = xb_add(&bar[XB_XSUB(b.x)], 1u);
        const unsigned gen = old / nloc;
        if (old + 1u == (gen + 1u) * nloc) {
            __builtin_amdgcn_fence(__ATOMIC_RELEASE, "agent");
            asm volatile("s_waitcnt vmcnt(0)" ::: "memory");
            const unsigned og = xb_add(&bar[XB_TOP], 1u);
            const unsigned tg = og / nx;
            if (og + 1u == (tg + 1u) * nx) xb_add(&bar[XB_TOPGEN], 1u);
            else XB_SPIN(xb_ld(&bar[XB_TOPGEN]) == tg, bar);
            __builtin_amdgcn_fence(__ATOMIC_ACQUIRE, "agent");
            xb_add(&bar[XB_XGEN(b.x)], 1u);
            asm volatile("s_waitcnt vmcnt(0)" ::: "memory");
        } else {
            XB_SPIN(xb_ld(&bar[XB_XGEN(b.x)]) == gen, bar);
            __builtin_amdgcn_fence(__ATOMIC_ACQUIRE, "agent");
            asm volatile("s_waitcnt vmcnt(0)" ::: "memory");
        }
    }
    __syncthreads();
}

namespace pg8 {
constexpr int BM = 256, BK = 64, HALF = 128, HTB = HALF * BK * 2, STAGE_BYTES = 8 * HTB, NXCD = 8, WGM = 8;
__host__ __device__ __forceinline__ int lds_byte(int r, int c) { const int st = (r >> 4) * 2 + (c >> 5), rr = r & 15, cc = c & 31, ob = rr * 64 + cc * 2; return st * 1024 + (ob ^ (((ob >> 9) & 1) << 5)); }
__host__ __device__ __forceinline__ void stage_rc(int b, int& R, int& C) { const int st = b / 1024, sb = b % 1024, swz = sb ^ (((sb >> 9) & 1) << 5); R = (st >> 1) * 16 + swz / 64; C = (st & 1) * 32 + (swz % 64) / 2; }
__host__ __device__ __forceinline__ int perm32(int rho) { const int n = rho >> 4, i = rho & 15; return 8 * (i >> 2) + 4 * n + (i & 3); }

struct Unit { int pm, pn, am, ex; size_t bo; };
typedef int i32x4 __attribute__((ext_vector_type(4)));
typedef int i32x8 __attribute__((ext_vector_type(8)));
typedef short bf16x16 __attribute__((ext_vector_type(16)));
struct Gemm { const bf16_t* A; const bf16_t* Bt; int K; int lda, ldb; };

__device__ __forceinline__ bool tile_of(long L, int nM, int nN, int& pm, int& pn) {
    const int nwg = nM * nN; if (L >= nwg) return false;
    int wgid = (int)L; { const int q = nwg / NXCD, r = nwg % NXCD, xcd = wgid % NXCD, off = wgid / NXCD; wgid = (xcd < r ? xcd * (q + 1) : r * (q + 1) + (xcd - r) * q) + off; }
    const int nig = WGM * nN, gid = wgid / nig, fm = gid * WGM, gsz = (nM - fm) < WGM ? (nM - fm) : WGM;
    pm = fm + ((wgid % nig) % gsz); pn = (wgid % nig) / gsz; return true;
}
struct RowOrder {
    int nM, nN, G, c, latent_only;
    __device__ __forceinline__ bool next(int i, Unit& u) const {
        int pm, pn; if (!tile_of((long)i * G + c, nM, nN, pm, pn)) return false;
        if (latent_only) pm = (pm >> 3) * 9 + 1 + (pm & 7);
        u.pm = pm; u.am = pm; u.pn = pn; u.bo = 0; u.ex = 0; return true;
    }
};
struct MoeOrder {
    int nM, nN, G, c, t0, a_rel, o_rel; const LAS unsigned* tile_expert; size_t expert_bytes;
    __device__ __forceinline__ bool next(int i, Unit& u) const {
        int pm, pn; if (nM <= 0 || !tile_of((long)i * G + c, nM, nN, pm, pn)) return false;
        u.pm = o_rel ? pm : t0 + pm; u.am = a_rel ? pm : t0 + pm; u.pn = pn; u.ex = __builtin_amdgcn_readfirstlane((int)tile_expert[t0 + pm]); u.bo = (size_t)u.ex * expert_bytes; return true;
    }
};

template <int MODE, int N> struct FragSet { bf16x8 s[N][2]; };
template <int N> struct FragSet<2, N> { bf16x16 w[N]; };
template <class Epi, class Sched, int MODE = 0>
__device__ __forceinline__ void gemm_phase(LAS unsigned char* lds, const Gemm g, const Sched& S, const Epi& E) {
    int tid_ = threadIdx.x; asm volatile("" : "+v"(tid_));
    const int tid = tid_, wid = __builtin_amdgcn_readfirstlane(tid >> 6), lane = tid & 63, wr = wid >> 2, wc = wid & 3, fr = lane & 15, fq = lane >> 4;
    constexpr bool I8 = MODE == 1;
    int f8scale = 0x7f7f7f7f; asm volatile("" : "+v"(f8scale));
    const int K = g.K, nt = K / BK, lda = g.lda ? g.lda : K, ldb = g.ldb ? g.ldb : K;
    unsigned voffA[2], voffB[2];
#pragma unroll
    for (int i = 0; i < 2; ++i) { int R, C; stage_rc(tid * 16 + i * 8192, R, C); const int Rb = Epi::PERM ? ((R & ~31) + perm32(R & 31)) : R;
        voffA[i] = (unsigned)(R * lda + C) * 2u; voffB[i] = (unsigned)(Rb * ldb + C) * 2u; }
    const size_t kstep = (size_t)(BK * 2);
    const size_t hstepA = (size_t)HALF * lda * 2, hstepB = (size_t)HALF * ldb * 2;
    const size_t tstepA = 2 * hstepA, tstepB = 2 * hstepB;
    const unsigned ldsw = (unsigned)wid * 1024u;
    const int aoff = lds_byte(wr * 64 + fr, fq * 8), boff = lds_byte(wc * 32 + fr, fq * 8);
#define PG8_SA(b, h) (((b) * 2 + (h)) * HTB)
#define PG8_SB(b, h) ((4 + (b) * 2 + (h)) * HTB)
#define PG8_STAGE(bufoff, gbase, voff) do { _Pragma("unroll") for (int _i = 0; _i < 2; ++_i) \
        __builtin_amdgcn_global_load_lds((const unsigned*)((const char*)(gbase) + (voff)[_i]), (LAS unsigned*)(lds + (bufoff) + ldsw + _i * 8192), 16, 0, 0); } while (0)
#define PG8_LDA(dst, b, h) do { if constexpr (MODE == 2) { _Pragma("unroll") for (int m = 0; m < 4; ++m) dst.w[m] = __builtin_shufflevector(*(const LAS bf16x8*)(lds + PG8_SA(b, h) + aoff + m * 2048), *(const LAS bf16x8*)(lds + PG8_SA(b, h) + aoff + m * 2048 + 1024), 0, 1, 2, 3, 4, 5, 6, 7, 8, 9, 10, 11, 12, 13, 14, 15); } \
        else { _Pragma("unroll") for (int m = 0; m < 4; ++m) _Pragma("unroll") for (int k = 0; k < 2; ++k) dst.s[m][k] = *(const LAS bf16x8*)(lds + PG8_SA(b, h) + aoff + m * 2048 + k * 1024); } } while (0)
#define PG8_LDB(dst, b, h) do { if constexpr (MODE == 2) { _Pragma("unroll") for (int n = 0; n < 2; ++n) dst.w[n] = __builtin_shufflevector(*(const LAS bf16x8*)(lds + PG8_SB(b, h) + boff + n * 2048), *(const LAS bf16x8*)(lds + PG8_SB(b, h) + boff + n * 2048 + 1024), 0, 1, 2, 3, 4, 5, 6, 7, 8, 9, 10, 11, 12, 13, 14, 15); } \
        else { _Pragma("unroll") for (int n = 0; n < 2; ++n) _Pragma("unroll") for (int k = 0; k < 2; ++k) dst.s[n][k] = *(const LAS bf16x8*)(lds + PG8_SB(b, h) + boff + n * 2048 + k * 1024); } } while (0)
#define PG8_MMA(ai, bj, At, Bt) do { __builtin_amdgcn_s_setprio(1); \
        if constexpr (MODE == 2) { _Pragma("unroll") for (int m = 0; m < 4; ++m) _Pragma("unroll") for (int n = 0; n < 2; ++n) \
            asm volatile("v_mfma_scale_f32_16x16x128_f8f6f4 %0, %1, %2, %0, %3, %3 op_sel_hi:[0,0,0]" : "+v"(acc[ai][bj][m][n]) : "v"(__builtin_bit_cast(i32x8, Bt.w[n])), "v"(__builtin_bit_cast(i32x8, At.w[m])), "v"(f8scale)); } \
        else { _Pragma("unroll") for (int m = 0; m < 4; ++m) _Pragma("unroll") for (int n = 0; n < 2; ++n) _Pragma("unroll") for (int k = 0; k < 2; ++k) \
        { if constexpr (I8) acc[ai][bj][m][n] = __builtin_bit_cast(f32x4, __builtin_amdgcn_mfma_i32_16x16x64_i8(__builtin_bit_cast(i32x4, Bt.s[n][k]), __builtin_bit_cast(i32x4, At.s[m][k]), __builtin_bit_cast(i32x4, acc[ai][bj][m][n]), 0, 0, 0)); \
          else acc[ai][bj][m][n] = __builtin_amdgcn_mfma_f32_16x16x32_bf16(Bt.s[n][k], At.s[m][k], acc[ai][bj][m][n], 0, 0, 0); } } __builtin_amdgcn_s_setprio(0); } while (0)
#define PG8_WAIT_V(n) asm volatile("s_waitcnt vmcnt(" #n ")" ::: "memory")
#define PG8_WAIT_L(n) asm volatile("s_waitcnt lgkmcnt(" #n ")" ::: "memory")
#define PG8_BAR __builtin_amdgcn_s_barrier()
#define PG8_SCHED __builtin_amdgcn_sched_barrier(0)
    Unit cur, nxt; int ui = 0;
    if (!S.next(0, cur)) return;
    constexpr int PRE_BASE = STAGE_BYTES;
#define PG8_PRE(u_, sel_) do { if constexpr (Epi::NPRE > 0) { if (wid == 0) { _Pragma("unroll") for (int k_ = 0; k_ < Epi::NPRE; ++k_) \
        __builtin_amdgcn_global_load_lds((const unsigned*)(E.pre_src(u_, k_) + lane * 4), (LAS unsigned*)(lds + PRE_BASE + (sel_) * 2048 + k_ * 1024), 16, 0, 0); } } } while (0)
    PG8_PRE(cur, 0);
    f32x4 acc[2][2][4][2];
#pragma unroll
    for (int a = 0; a < 2; ++a)
#pragma unroll
        for (int b = 0; b < 2; ++b)
#pragma unroll
            for (int m = 0; m < 4; ++m)
#pragma unroll
                for (int n = 0; n < 2; ++n) acc[a][b][m][n] = (f32x4){0.f, 0.f, 0.f, 0.f};
    FragSet<MODE, 4> At; FragSet<MODE, 2> B0, B1;
    const char* cA = (const char*)g.A + (size_t)cur.am * tstepA; const char* cB = (const char*)g.Bt + cur.bo + (size_t)cur.pn * tstepB;
    PG8_STAGE(PG8_SB(0, 0), cB, voffB); PG8_STAGE(PG8_SA(0, 0), cA, voffA); PG8_STAGE(PG8_SB(0, 1), cB + hstepB, voffB); PG8_STAGE(PG8_SA(0, 1), cA + hstepA, voffA);
    if (wr == 1) PG8_BAR;
    PG8_WAIT_V(4); PG8_BAR;
    PG8_STAGE(PG8_SB(1, 0), cB + kstep, voffB); PG8_STAGE(PG8_SA(1, 0), cA + kstep, voffA); PG8_STAGE(PG8_SB(1, 1), cB + hstepB + kstep, voffB);
    PG8_WAIT_V(6); PG8_BAR;
    for (;;) {
        const bool has_next = S.next(ui + 1, nxt);
        const char* nA = has_next ? (const char*)g.A + (size_t)nxt.am * tstepA : cA; const char* nB = has_next ? (const char*)g.Bt + nxt.bo + (size_t)nxt.pn * tstepB : cB;
        for (int t = 0; t < nt; t += 2) {
            const bool last = (t == nt - 2);
            const char* a1 = cA + (size_t)(t + 1) * kstep;
            const char* a2 = last ? nA : cA + (size_t)(t + 2) * kstep; const char* b2 = last ? nB : cB + (size_t)(t + 2) * kstep;
            const char* a3 = a2 + kstep; const char* b3 = b2 + kstep;
            PG8_LDB(B0, 0, 0); PG8_SCHED; PG8_LDA(At, 0, 0); PG8_STAGE(PG8_SA(1, 1), a1 + hstepA, voffA);
            PG8_WAIT_L(8); PG8_BAR; PG8_WAIT_L(0); PG8_MMA(0, 0, At, B0); PG8_BAR; PG8_SCHED;
            PG8_LDB(B1, 0, 1); PG8_STAGE(PG8_SB(0, 0), b2, voffB);
            PG8_BAR; PG8_WAIT_L(0); PG8_MMA(0, 1, At, B1); PG8_BAR;
            PG8_LDA(At, 0, 1); PG8_STAGE(PG8_SA(0, 0), a2, voffA);
            PG8_BAR; PG8_WAIT_L(0); PG8_MMA(1, 0, At, B0); PG8_BAR; PG8_SCHED;
            PG8_STAGE(PG8_SB(0, 1), b2 + hstepB, voffB);
            PG8_WAIT_V(6); PG8_BAR; PG8_MMA(1, 1, At, B1); PG8_BAR;
            PG8_LDB(B0, 1, 0); PG8_SCHED; PG8_LDA(At, 1, 0); PG8_STAGE(PG8_SA(0, 1), a2 + hstepA, voffA);
            PG8_WAIT_L(8); PG8_BAR; PG8_WAIT_L(0); PG8_MMA(0, 0, At, B0); PG8_BAR; PG8_SCHED;
            PG8_LDB(B1, 1, 1); PG8_STAGE(PG8_SB(1, 0), b3, voffB);
            PG8_BAR; PG8_WAIT_L(0); PG8_MMA(0, 1, At, B1); PG8_BAR;
            PG8_LDA(At, 1, 1); PG8_STAGE(PG8_SA(1, 0), a3, voffA);
            PG8_BAR; PG8_WAIT_L(0); PG8_MMA(1, 0, At, B0); PG8_BAR; PG8_SCHED;
            PG8_STAGE(PG8_SB(1, 1), b3 + hstepB, voffB);
            PG8_WAIT_V(6); PG8_BAR; PG8_MMA(1, 1, At, B1); PG8_BAR;
        }
        if constexpr (MODE == 2) asm volatile("s_nop 15\n\ts_nop 15" ::: "memory");
        if constexpr (I8) {
#pragma unroll
            for (int a = 0; a < 2; ++a)
#pragma unroll
                for (int b = 0; b < 2; ++b)
#pragma unroll
                    for (int m = 0; m < 4; ++m)
#pragma unroll
                        for (int n = 0; n < 2; ++n) { const i32x4 iv = __builtin_bit_cast(i32x4, acc[a][b][m][n]); acc[a][b][m][n] = (f32x4){(float)iv[0], (float)iv[1], (float)iv[2], (float)iv[3]}; }
        }
        if (has_next) PG8_PRE(nxt, (ui + 1) & 1);
        { int fr2 = fr, fq2 = fq; asm volatile("" : "+v"(fr2), "+v"(fq2));
          E(acc, cur, wr, wc, fr2, fq2, (const LAS float*)(lds + PRE_BASE + (ui & 1) * 2048)); }
        if (!has_next) break;
#pragma unroll
        for (int a = 0; a < 2; ++a)
#pragma unroll
            for (int b = 0; b < 2; ++b)
#pragma unroll
                for (int m = 0; m < 4; ++m)
#pragma unroll
                    for (int n = 0; n < 2; ++n) acc[a][b][m][n] = (f32x4){0.f, 0.f, 0.f, 0.f};
        cur = nxt; cA = nA; cB = nB; ++ui;
    }
    PG8_WAIT_V(0);
    if (wr == 0) PG8_BAR;
    PG8_BAR;
#undef PG8_SA
#undef PG8_SB
#undef PG8_STAGE
#undef PG8_LDA
#undef PG8_LDB
#undef PG8_MMA
#undef PG8_PRE
#undef PG8_WAIT_V
#undef PG8_WAIT_L
#undef PG8_BAR
#undef PG8_SCHED
}
}
using pg8::Unit;

typedef const float* const __attribute__((address_space(4)))* intab_t;
struct Frame {
    intab_t in; unsigned char* ws; unsigned* ctl; float* out;
    int tid, lane, wid, G, bid;
};
#define WSP(T, off) ((T*)(F.ws + (off)))
typedef const Args __attribute__((address_space(4)))* kargs_t;
__device__ __forceinline__ kargs_t kargs() { unsigned long long p = (unsigned long long)__builtin_amdgcn_kernarg_segment_ptr(); asm volatile("" : "+s"(p)); return (kargs_t)p; }
__device__ __forceinline__ Frame make_frame() {
    Frame F; kargs_t ka = kargs(); F.in = (intab_t)ka; F.ws = ka->ws; F.ctl = (unsigned*)(ka->ws + WS_CTL); F.out = ka->out;
    int t = threadIdx.x; asm volatile("" : "+v"(t)); F.tid = t; F.lane = t & 63; F.wid = __builtin_amdgcn_readfirstlane(t >> 6); F.G = gridDim.x; F.bid = blockIdx.x; return F;
}

__device__ __forceinline__ void rope4(f32x4& v0, f32x4& v1, const f32x4* tab) {
    const f32x4 t0 = tab[0], t1 = tab[1];
    const float a0 = v0[0], b0 = v0[1], a1 = v0[2], b1 = v0[3], a2 = v1[0], b2 = v1[1], a3 = v1[2], b3 = v1[3];
    v0[0] = a0 * t0[0] - b0 * t0[1]; v0[1] = b0 * t0[0] + a0 * t0[1];
    v0[2] = a1 * t0[2] - b1 * t0[3]; v0[3] = b1 * t0[2] + a1 * t0[3];
    v1[0] = a2 * t1[0] - b2 * t1[1]; v1[1] = b2 * t1[0] + a2 * t1[1];
    v1[2] = a3 * t1[2] - b3 * t1[3]; v1[3] = b3 * t1[2] + a3 * t1[3];
}
struct EpiProj {
    static constexpr bool PERM = true; static constexpr int NPRE = 2;
    __device__ __forceinline__ const float* pre_src(const Unit& u, int k) const { return k == 0 ? cs + u.pn * 256 : rs + u.pm * 256; }
    bf16_t* P; const float* tabDA; const float* tabML; const float* rs; const float* cs; float* SS;
    __device__ __forceinline__ void operator()(const f32x4 (&acc)[2][2][4][2], const Unit& u, int wr, int wc, int fr, int fq, const LAS float* pre) const {
        const int kk = u.pm % 9; const bool latent = kk > 0;
        const int lane_ = fr + 16 * fq; float rsl[2];
#pragma unroll
        for (int ai = 0; ai < 2; ++ai) rsl[ai] = pre[256 + ai * 128 + wr * 64 + lane_];
#pragma unroll
        for (int bj = 0; bj < 2; ++bj) {
            const int col0 = u.pn * 256 + bj * 128 + wc * 32 + 8 * fq;
            if (col0 >= PLD) continue;
            int mode = 0, axis = 0, f0 = 0; float sc = 1.f;
            const f32x4 cs0 = *(const LAS f32x4*)(pre + bj * 128 + wc * 32 + 8 * fq), cs1 = *(const LAS f32x4*)(pre + bj * 128 + wc * 32 + 8 * fq + 4);
            if (col0 < C_DAV) { const int g = (col0 % 48) >> 3; mode = 1; axis = g / 3; f0 = (g % 3) * 4; if (col0 < C_DAK) sc = SC_DA; }
            else if (col0 >= C_KR) { const int g = (col0 - C_KR) >> 3; mode = 2; axis = g >> 1; f0 = (g & 1) * 4; }
            const f32x4 cq0 = cs0 * sc, cq1 = cs1 * sc;
            const bool dosum = u.pn == 7 ? bj == 1 : u.pn == 8; const int slot = u.pn == 7 ? 0 : 1 + bj;
#pragma unroll
            for (int ai = 0; ai < 2; ++ai) {
                float zsel = 0.f;
#pragma unroll
                for (int m = 0; m < 4; ++m) {
                    const int rl = ai * 128 + wr * 64 + m * 16 + fr;
                    const float rsv = __int_as_float(__builtin_amdgcn_ds_bpermute((m * 16 + fr) << 2, __float_as_int(rsl[ai])));
                    f32x4 v0 = acc[ai][bj][m][0] * cq0 * rsv, v1 = acc[ai][bj][m][1] * cq1 * rsv;
                    if (dosum) { float sq = ((v0[0] * v0[0] + v0[1] * v0[1]) + (v0[2] * v0[2] + v0[3] * v0[3])) + ((v1[0] * v1[0] + v1[1] * v1[1]) + (v1[2] * v1[2] + v1[3] * v1[3]));
                        { const auto r = __builtin_amdgcn_permlane16_swap(__float_as_uint(sq), __float_as_uint(sq), false, false); sq = __uint_as_float(r[0]) + __uint_as_float(r[1]); }
                        { const auto r = __builtin_amdgcn_permlane32_swap(__float_as_uint(sq), __float_as_uint(sq), false, false); sq = __uint_as_float(r[0]) + __uint_as_float(r[1]); }
                        if (fq == m) zsel = sq; }
                    if (mode && latent) {
                        const int t = (kk - 1) * 256 + rl; const int pos = axis ? (t & 63) : (t >> 6);
                        const f32x4* tab = mode == 1 ? (const f32x4*)(tabDA + (pos * 12 + f0) * 2) : (const f32x4*)(tabML + (pos * 8 + f0) * 2);
                        rope4(v0, v1, tab);
                    }
                    u32x4 w; w.x = cvt_pk_bf16(v0[0], v0[1]); w.y = cvt_pk_bf16(v0[2], v0[3]); w.z = cvt_pk_bf16(v1[0], v1[1]); w.w = cvt_pk_bf16(v1[2], v1[3]);
                    *(u32x4*)(P + (size_t)(u.pm * 256 + rl) * PLD + col0) = w;
                    __builtin_amdgcn_sched_barrier(0);
                }
                if (dosum) SS[(size_t)(u.pm * 256 + ai * 128 + wr * 64 + lane_) * 16 + slot * 4 + wc] = zsel;
            }
        }
    }
};
struct EpiMlaQ {
    static constexpr bool PERM = true; static constexpr int NPRE = 0;
    bf16_t* Q; const float* tabML; const float* SS;
    __device__ __forceinline__ void operator()(const f32x4 (&acc)[2][2][4][2], const Unit& u, int wr, int wc, int fr, int fq, const LAS float* pre) const {
        const int kk = u.pm % 9; const bool latent = kk > 0;
        const int lane_ = fr + 16 * fq; float rsl[2];
#pragma unroll
        for (int ai = 0; ai < 2; ++ai) { const f32x4* sp = (const f32x4*)(SS + (size_t)(u.pm * 256 + ai * 128 + wr * 64 + lane_) * 16); const f32x4 a = sp[0], b = sp[1];
            rsl[ai] = __builtin_amdgcn_rsqf((((a[0] + a[1]) + (a[2] + a[3])) + ((b[0] + b[1]) + (b[2] + b[3]))) * (1.0f / 256.0f) + RMS_EPS) * SC_ML; }
#pragma unroll
        for (int bj = 0; bj < 2; ++bj) {
            const int col0 = u.pn * 256 + bj * 128 + wc * 32 + 8 * fq;
            if (col0 >= MQLD) continue;
            const int d0 = col0 % 96; int mode = 0, axis = 0, f0 = 0;
            if (d0 >= 64) { const int g = (d0 - 64) >> 3; mode = 1; axis = g >> 1; f0 = (g & 1) * 4; }
#pragma unroll
            for (int ai = 0; ai < 2; ++ai)
#pragma unroll
                for (int m = 0; m < 4; ++m) {
                    const int rl = ai * 128 + wr * 64 + m * 16 + fr;
                    const float rsv = __int_as_float(__builtin_amdgcn_ds_bpermute((m * 16 + fr) << 2, __float_as_int(rsl[ai])));
                    f32x4 v0 = acc[ai][bj][m][0] * rsv, v1 = acc[ai][bj][m][1] * rsv;
                    if (mode && latent) {
                        const int t = (kk - 1) * 256 + rl; const int pos = axis ? (t & 63) : (t >> 6);
                        rope4(v0, v1, (const f32x4*)(tabML + (pos * 8 + f0) * 2));
                    }
                    u32x4 w; w.x = cvt_pk_bf16(v0[0], v0[1]); w.y = cvt_pk_bf16(v0[2], v0[3]); w.z = cvt_pk_bf16(v1[0], v1[1]); w.w = cvt_pk_bf16(v1[2], v1[3]);
                    *(u32x4*)(Q + (size_t)(u.pm * 256 + rl) * MQLD + col0) = w;
                    __builtin_amdgcn_sched_barrier(0);
                }
        }
    }
};
struct EpiBf16 {
    static constexpr bool PERM = true; static constexpr int NPRE = 1;
    __device__ __forceinline__ const float* pre_src(const Unit& u, int) const { return cs + (size_t)u.ex * 1024 + u.pn * 256; }
    bf16_t* O; int ldc; const float* cs; float mul;
    __device__ __forceinline__ void operator()(const f32x4 (&acc)[2][2][4][2], const Unit& u, int wr, int wc, int fr, int fq, const LAS float* pre) const {
#pragma unroll
        for (int bj = 0; bj < 2; ++bj) {
            const int col0 = u.pn * 256 + bj * 128 + wc * 32 + 8 * fq;
            const f32x4 c0 = *(const LAS f32x4*)(pre + bj * 128 + wc * 32 + 8 * fq) * mul, c1 = *(const LAS f32x4*)(pre + bj * 128 + wc * 32 + 8 * fq + 4) * mul;
#pragma unroll
            for (int ai = 0; ai < 2; ++ai)
#pragma unroll
                for (int m = 0; m < 4; ++m) {
                    const int rl = ai * 128 + wr * 64 + m * 16 + fr;
                    const f32x4 v0 = acc[ai][bj][m][0] * c0, v1 = acc[ai][bj][m][1] * c1;
                    u32x4 w; w.x = cvt_pk_bf16(v0[0], v0[1]); w.y = cvt_pk_bf16(v0[2], v0[3]); w.z = cvt_pk_bf16(v1[0], v1[1]); w.w = cvt_pk_bf16(v1[2], v1[3]);
                    *(u32x4*)(O + (size_t)(u.pm * 256 + rl) * ldc + col0) = w;
                }
        }
    }
};
struct EpiMlaKV {
    static constexpr bool PERM = true; static constexpr int NPRE = 0;
    bf16_t* O; const float* SS;
    __device__ __forceinline__ void operator()(const f32x4 (&acc)[2][2][4][2], const Unit& u, int wr, int wc, int fr, int fq, const LAS float* pre) const {
        const int lane_ = fr + 16 * fq; float rsl[2];
#pragma unroll
        for (int ai = 0; ai < 2; ++ai) { const f32x4 a = *(const f32x4*)(SS + (size_t)(u.pm * 256 + ai * 128 + wr * 64 + lane_) * 16 + 8);
            rsl[ai] = __builtin_amdgcn_rsqf(((a[0] + a[1]) + (a[2] + a[3])) * (1.0f / 128.0f) + RMS_EPS); }
#pragma unroll
        for (int bj = 0; bj < 2; ++bj) {
            const int col0 = u.pn * 256 + bj * 128 + wc * 32 + 8 * fq;
#pragma unroll
            for (int ai = 0; ai < 2; ++ai)
#pragma unroll
                for (int m = 0; m < 4; ++m) {
                    const int rl = ai * 128 + wr * 64 + m * 16 + fr;
                    const float rsv = __int_as_float(__builtin_amdgcn_ds_bpermute((m * 16 + fr) << 2, __float_as_int(rsl[ai])));
                    const f32x4 v0 = acc[ai][bj][m][0] * rsv, v1 = acc[ai][bj][m][1] * rsv;
                    u32x4 w; w.x = cvt_pk_bf16(v0[0], v0[1]); w.y = cvt_pk_bf16(v0[2], v0[3]); w.z = cvt_pk_bf16(v1[0], v1[1]); w.w = cvt_pk_bf16(v1[2], v1[3]);
                    *(u32x4*)(O + (size_t)(u.pm * 256 + rl) * MKVLD + col0) = w;
                    __builtin_amdgcn_sched_barrier(0);
                }
        }
    }
};
struct EpiSwiglu {
    static constexpr bool PERM = true; static constexpr int NPRE = 2;
    __device__ __forceinline__ const float* pre_src(const Unit& u, int k) const { return k == 0 ? cs + (size_t)u.ex * 5632 + u.pn * 256 : rs + u.am * 256; }
    unsigned char* H; const float* rs; const float* cs;
    __device__ __forceinline__ void operator()(const f32x4 (&acc)[2][2][4][2], const Unit& u, int wr, int wc, int fr, int fq, const LAS float* pre) const {
        const int col0 = u.pn * 128 + wc * 32 + 8 * fq; const int rt = u.pm;
        const float* csp = cs + (size_t)u.ex * 5632 + u.pn * 256 + wc * 32 + 8 * fq;
        f32x4 cg[2], cu[2];
#pragma unroll
        for (int n = 0; n < 2; ++n) { cg[n] = *(const LAS f32x4*)(pre + wc * 32 + 8 * fq + 4 * n) * LOG2E; cu[n] = *(const LAS f32x4*)(pre + 128 + wc * 32 + 8 * fq + 4 * n) * (HSCL / LOG2E); }
        const int lane_ = fr + 16 * fq; float rsl[2];
#pragma unroll
        for (int ai = 0; ai < 2; ++ai) rsl[ai] = pre[256 + ai * 128 + wr * 64 + lane_];
#pragma unroll
        for (int ai = 0; ai < 2; ++ai)
#pragma unroll
            for (int mp = 0; mp < 2; ++mp) {
                u32x2 w[2];
#pragma unroll
                for (int q = 0; q < 2; ++q) { const int m = 2 * mp + q;
                    const int rl = ai * 128 + wr * 64 + m * 16 + fr;
                    float h[8]; const float rsv = __int_as_float(__builtin_amdgcn_ds_bpermute((m * 16 + fr) << 2, __float_as_int(rsl[ai])));
#pragma unroll
                    for (int n = 0; n < 2; ++n)
#pragma unroll
                        for (int e = 0; e < 4; ++e) { const float gv = acc[ai][0][m][n][e] * cg[n][e] * rsv, uv = acc[ai][1][m][n][e] * cu[n][e] * rsv;
                            const float sg = gv * __builtin_amdgcn_rcpf(1.0f + fast_exp2(-gv));
                            h[n * 4 + e] = __builtin_amdgcn_fmed3f(sg * uv, -448.0f, 448.0f); }
                    int t0 = __builtin_amdgcn_cvt_pk_fp8_f32(h[0], h[1], 0, false); t0 = __builtin_amdgcn_cvt_pk_fp8_f32(h[2], h[3], t0, true);
                    int t1 = __builtin_amdgcn_cvt_pk_fp8_f32(h[4], h[5], 0, false); t1 = __builtin_amdgcn_cvt_pk_fp8_f32(h[6], h[7], t1, true); w[q].x = (unsigned)t0; w[q].y = (unsigned)t1; }
                const auto r0 = __builtin_amdgcn_permlane16_swap(w[0].x, w[1].x, false, false); const auto r1 = __builtin_amdgcn_permlane16_swap(w[0].y, w[1].y, false, false);
                const int rl2 = ai * 128 + wr * 64 + (2 * mp + (fq & 1)) * 16 + fr;
                *(u32x4*)(H + (size_t)(rt * 256 + rl2) * FF + col0 - 8 * (fq & 1)) = (u32x4){r0[0], r1[0], r0[1], r1[1]};
            }
    }
};
template <bool FIRST = false>
struct EpiResid {
    static constexpr bool PERM = true; static constexpr int NPRE = 0;
    bf16_t* Y; const bf16_t* XH; const float* gate; const float* cs; float mul;
    __device__ __forceinline__ void operator()(const f32x4 (&acc)[2][2][4][2], const Unit& u, int wr, int wc, int fr, int fq, const LAS float* pre) const {
        const int b = u.pm / 9, kk = u.pm % 9; const float* gp = gate + (size_t)(kk ? b : 16) * 6144;
        const int col0 = u.pn * 256 + wc * 32 + 8 * fq;
        const float* src0 = nullptr;
        if (FIRST) { kargs_t ka = kargs(); src0 = kk ? ka->in[0] + ((size_t)b * SEQ + (size_t)(kk - 1) * 256) * 1024 : ka->in[2] + (size_t)b * CTXL * 1024; }
        f32x4 gv[2][2];
#pragma unroll
        for (int bj = 0; bj < 2; ++bj)
#pragma unroll
            for (int n = 0; n < 2; ++n) { gv[bj][n] = *(const f32x4*)(gp + col0 + bj * 128 + n * 4); if (cs) gv[bj][n] *= *(const f32x4*)(cs + col0 + bj * 128 + n * 4) * mul; }
        if (!FIRST) {
            u32x4 hres[2][4][2];
#pragma unroll
            for (int ai = 0; ai < 2; ++ai)
#pragma unroll
                for (int m = 0; m < 4; ++m)
#pragma unroll
                    for (int bj = 0; bj < 2; ++bj) hres[ai][m][bj] = *(const u32x4*)(XH + (size_t)(u.pm * 256 + ai * 128 + wr * 64 + m * 16 + fr) * 1024 + col0 + bj * 128);
            __builtin_amdgcn_sched_barrier(0);
#pragma unroll
            for (int ai = 0; ai < 2; ++ai)
#pragma unroll
                for (int m = 0; m < 4; ++m) {
                    const size_t ro = (size_t)(u.pm * 256 + ai * 128 + wr * 64 + m * 16 + fr) * 1024 + col0;
#pragma unroll
                    for (int bj = 0; bj < 2; ++bj) {
                        const u32x4 h = hres[ai][m][bj]; const f32x2 a0 = unpk_f16(h.x), a1 = unpk_f16(h.y), a2 = unpk_f16(h.z), a3 = unpk_f16(h.w);
                        const f32x4 r0 = {a0[0], a0[1], a1[0], a1[1]}, r1 = {a2[0], a2[1], a3[0], a3[1]};
                        const f32x4 y0 = r0 * ALPHA + gv[bj][0] * acc[ai][bj][m][0], y1 = r1 * ALPHA + gv[bj][1] * acc[ai][bj][m][1];
                        u32x4 w; w.x = cvt_pk_f16(y0[0], y0[1]); w.y = cvt_pk_f16(y0[2], y0[3]); w.z = cvt_pk_f16(y1[0], y1[1]); w.w = cvt_pk_f16(y1[2], y1[3]);
                        *(u32x4*)(Y + ro + bj * 128) = w;
                    }
                    __builtin_amdgcn_sched_barrier(0);
                }
        } else {
#pragma unroll
            for (int ai = 0; ai < 2; ++ai) {
                f32x4 fres[4][2][2];
#pragma unroll
                for (int m = 0; m < 4; ++m)
#pragma unroll
                    for (int bj = 0; bj < 2; ++bj) { const float* sp = src0 + (size_t)(ai * 128 + wr * 64 + m * 16 + fr) * 1024 + col0 + bj * 128; fres[m][bj][0] = *(const f32x4*)sp; fres[m][bj][1] = *(const f32x4*)(sp + 4); }
                __builtin_amdgcn_sched_barrier(0);
#pragma unroll
                for (int m = 0; m < 4; ++m) {
                    const size_t ro = (size_t)(u.pm * 256 + ai * 128 + wr * 64 + m * 16 + fr) * 1024 + col0;
#pragma unroll
                    for (int bj = 0; bj < 2; ++bj) {
                        const f32x4 y0 = fres[m][bj][0] * ALPHA + gv[bj][0] * acc[ai][bj][m][0], y1 = fres[m][bj][1] * ALPHA + gv[bj][1] * acc[ai][bj][m][1];
                        u32x4 w; w.x = cvt_pk_f16(y0[0], y0[1]); w.y = cvt_pk_f16(y0[2], y0[3]); w.z = cvt_pk_f16(y1[0], y1[1]); w.w = cvt_pk_f16(y1[2], y1[3]);
                        *(u32x4*)(Y + ro + bj * 128) = w;
                    }
                    __builtin_amdgcn_sched_barrier(0);
                }
            }
        }
    }
};

__device__ __forceinline__ int map_win(int n) {
    if (n < C_DAV) { const int base = n >= C_DAK ? C_DAK : 0; const int r = n - base; const int hd = r / 96, rem = r % 96, mp = rem / 48, r48 = rem % 48, half = r48 / 24, p = r48 % 24;
        return base + hd * 96 + mp * 48 + half * 24 + (p >> 1) + 12 * (p & 1); }
    if (n < C_KR) return n;
    if (n < PLD) { const int p = n - C_KR, half = p >> 4, pp = p & 15; return C_KR + half * 16 + (pp >> 1) + 8 * (pp & 1); }
    return -1;
}
__device__ __forceinline__ int map_uq(int n) {
    if (n >= MQLD) return -1;
    const int hd = n / 96, d = n % 96; if (d < 64) return n;
    const int p = d - 64, half = p >> 4, pp = p & 15; return hd * 96 + 64 + half * 16 + (pp >> 1) + 8 * (pp & 1);
}
__device__ __forceinline__ int map_gu(int n) { const int t = n >> 8, bj = (n >> 7) & 1, j = n & 127; return (t * 128 + j) | (bj << 30); }
__device__ __forceinline__ int map_id(int n) { return n; }

template <int MAPID>
__device__ __forceinline__ void convert_tile(const Frame& F, LAS float* tile, const float* src0, const float* src1, int Nsrc, int K, bf16_t* dst, int Kd, const float* kscale, int n0, int k0) {
    if (MAPID >= 2) {
        const int c4 = F.tid & 15, kr = F.tid >> 4;
        const int col = MAPID == 2 ? map_gu(n0) : n0; const float* src = (col & (1 << 30)) ? src1 : src0; const int cb = (col & ~(1 << 30)) + 4 * c4;
        f32x4 v[8];
#pragma unroll
        for (int i = 0; i < 8; ++i) { const int k = k0 + kr + 32 * i; v[i] = k < K ? *(const f32x4*)(src + (size_t)k * Nsrc + cb) : (f32x4){0.f, 0.f, 0.f, 0.f}; }
#pragma unroll
        for (int i = 0; i < 8; ++i) { const int kk = kr + 32 * i; float sc = 1.f; if (kscale) sc = (k0 + kk) < K ? kscale[k0 + kk] : 0.f;
            tile[kk * 65 + 4 * c4 + 0] = v[i][0] * sc; tile[kk * 65 + 4 * c4 + 1] = v[i][1] * sc; tile[kk * 65 + 4 * c4 + 2] = v[i][2] * sc; tile[kk * 65 + 4 * c4 + 3] = v[i][3] * sc; }
    } else {
        const int nn = F.tid & 63, kq = F.tid >> 6;
        const int col = MAPID == 0 ? map_win(n0 + nn) : map_uq(n0 + nn);
        float v[32];
#pragma unroll
        for (int i = 0; i < 32; ++i) { const int k = k0 + kq + 8 * i; v[i] = (col >= 0 && k < K) ? src0[(size_t)k * Nsrc + col] : 0.f; }
#pragma unroll
        for (int i = 0; i < 32; ++i) { const int kk = kq + 8 * i; float sc = 1.f; if (kscale) sc = (k0 + kk) < K ? kscale[k0 + kk] : 0.f; tile[kk * 65 + nn] = v[i] * sc; }
    }
    __syncthreads();
    { const int n = F.tid >> 3, kc = F.tid & 7;
#pragma unroll
      for (int i = 0; i < 4; ++i) { const int k8 = (kc + 8 * i) * 8; float v[8];
#pragma unroll
          for (int j = 0; j < 8; ++j) v[j] = tile[(k8 + j) * 65 + n];
          u32x4 w; w.x = cvt_pk_bf16(v[0], v[1]); w.y = cvt_pk_bf16(v[2], v[3]); w.z = cvt_pk_bf16(v[4], v[5]); w.w = cvt_pk_bf16(v[6], v[7]);
          *(u32x4*)(dst + (size_t)(n0 + n) * Kd + k0 + k8) = w; } }
    __syncthreads();
}
template <int MAPID>
__device__ __forceinline__ void convert_matrix(const Frame& F, LAS float* tile, const float* src0, const float* src1, int Nsrc, int K, bf16_t* dst, int Kd, int nrows, const float* kscale, int rot) {
    const int kt = Kd / 256, ntile = (nrows / 64) * kt;
    int u0 = F.bid - rot; if (u0 < 0) u0 += F.G;
    for (int u = u0; u < ntile; u += F.G) convert_tile<MAPID>(F, tile, src0, src1, Nsrc, K, dst, Kd, kscale, (u / kt) * 64, (u % kt) * 256);
}
template <int MAPID, int FMT = 0, int KTOT = 1024>
__device__ __forceinline__ void convert_unit_i8(const Frame& F, LAS float* tile, const float* src0, const float* src1, int Nsrc, signed char* dst, float* scl, int n0) {
    constexpr float QMAX = FMT ? 224.0f : 127.0f;
    LAS unsigned* cmax = (LAS unsigned*)(tile + 256 * 65);
    if (F.tid < 64) cmax[F.tid] = 0u;
    __syncthreads();
    const int c4 = F.tid & 15, kr = F.tid >> 4, nn = F.tid & 63, kq = F.tid >> 6;
    int colv = 0; const float* srcv = src0; int cols = 0;
    if (MAPID >= 2) { const int col = MAPID == 2 ? map_gu(n0) : n0; srcv = (col & (1 << 30)) ? src1 : src0; colv = (col & ~(1 << 30)) + 4 * c4; }
    else cols = map_win(n0 + nn);
#pragma unroll 1
    for (int sweep = 0; sweep < 2; ++sweep) {
        float iv0 = 0.f, iv1 = 0.f, iv2 = 0.f, iv3 = 0.f;
        if (sweep) { if (MAPID >= 2) { const float m0 = __uint_as_float(cmax[4 * c4]), m1 = __uint_as_float(cmax[4 * c4 + 1]), m2 = __uint_as_float(cmax[4 * c4 + 2]), m3 = __uint_as_float(cmax[4 * c4 + 3]);
                iv0 = m0 > 0.f ? QMAX / m0 : 0.f; iv1 = m1 > 0.f ? QMAX / m1 : 0.f; iv2 = m2 > 0.f ? QMAX / m2 : 0.f; iv3 = m3 > 0.f ? QMAX / m3 : 0.f; }
            else { const float m0 = __uint_as_float(cmax[nn]); iv0 = m0 > 0.f ? QMAX / m0 : 0.f; }
            if (F.tid < 64) scl[n0 + F.tid] = __uint_as_float(cmax[F.tid]) * (1.0f / QMAX); }
        float pm0 = 0.f, pm1 = 0.f, pm2 = 0.f, pm3 = 0.f;
#pragma unroll 1
        for (int k0 = 0; k0 < KTOT; k0 += 256) {
            if (MAPID >= 2) {
                f32x4 v[8];
#pragma unroll
                for (int i = 0; i < 8; ++i) v[i] = *(const f32x4*)(srcv + (size_t)(k0 + kr + 32 * i) * Nsrc + colv);
                if (!sweep) {
#pragma unroll
                    for (int i = 0; i < 8; ++i) { pm0 = fmaxf(pm0, fabsf(v[i][0])); pm1 = fmaxf(pm1, fabsf(v[i][1])); pm2 = fmaxf(pm2, fabsf(v[i][2])); pm3 = fmaxf(pm3, fabsf(v[i][3])); }
                } else {
#pragma unroll
                    for (int i = 0; i < 8; ++i) { const int kk = kr + 32 * i; tile[kk * 65 + 4 * c4 + 0] = v[i][0] * iv0; tile[kk * 65 + 4 * c4 + 1] = v[i][1] * iv1; tile[kk * 65 + 4 * c4 + 2] = v[i][2] * iv2; tile[kk * 65 + 4 * c4 + 3] = v[i][3] * iv3; }
                }
            } else {
                float v[32];
#pragma unroll
                for (int i = 0; i < 32; ++i) v[i] = cols >= 0 ? src0[(size_t)(k0 + kq + 8 * i) * Nsrc + cols] : 0.f;
                if (!sweep) {
#pragma unroll
                    for (int i = 0; i < 32; ++i) pm0 = fmaxf(pm0, fabsf(v[i]));
                } else {
#pragma unroll
                    for (int i = 0; i < 32; ++i) tile[(kq + 8 * i) * 65 + nn] = v[i] * iv0;
                }
            }
            if (sweep) {
                __syncthreads();
                { const int n = F.tid >> 3, kc = F.tid & 7;
#pragma unroll
                  for (int i = 0; i < 2; ++i) { const int k16 = (kc + 8 * i) * 16; unsigned w[4];
#pragma unroll
                      for (int j = 0; j < 4; ++j) { f32x4 q; q[0] = tile[(k16 + 4 * j) * 65 + n]; q[1] = tile[(k16 + 4 * j + 1) * 65 + n]; q[2] = tile[(k16 + 4 * j + 2) * 65 + n]; q[3] = tile[(k16 + 4 * j + 3) * 65 + n];
                          if (FMT == 0) { q[0] = rintf(q[0]); q[1] = rintf(q[1]); q[2] = rintf(q[2]); q[3] = rintf(q[3]); w[j] = pack_i8x4(q); }
                          else { int t = __builtin_amdgcn_cvt_pk_fp8_f32(q[0], q[1], 0, false); t = __builtin_amdgcn_cvt_pk_fp8_f32(q[2], q[3], t, true); w[j] = (unsigned)t; } }
                      *(u32x4*)(dst + (size_t)(n0 + n) * KTOT + k0 + k16) = (u32x4){w[0], w[1], w[2], w[3]}; } }
                __syncthreads();
            }
        }
        if (!sweep) {
            if (MAPID >= 2) { atomicMax((unsigned*)cmax + 4 * c4, __float_as_uint(pm0)); atomicMax((unsigned*)cmax + 4 * c4 + 1, __float_as_uint(pm1)); atomicMax((unsigned*)cmax + 4 * c4 + 2, __float_as_uint(pm2)); atomicMax((unsigned*)cmax + 4 * c4 + 3, __float_as_uint(pm3)); }
            else atomicMax((unsigned*)cmax + nn, __float_as_uint(pm0));
            __syncthreads();
        }
    }
    __syncthreads();
}
__device__ __forceinline__ void convert_unit_gu32(const Frame& F, LAS float* tile, const float* src0, const float* src1, signed char* dst, float* scl, int n0) {
    LAS unsigned* cmax = (LAS unsigned*)(tile + 1024 * 33);
    if (F.tid < 32) cmax[F.tid] = 0u;
    __syncthreads();
    const int c4 = F.tid & 7, kr = F.tid >> 3;
    const int col = map_gu(n0); const float* srcv = ((col & (1 << 30)) ? src1 : src0) + (col & ~(1 << 30)) + 4 * c4;
    float pm0 = 0.f, pm1 = 0.f, pm2 = 0.f, pm3 = 0.f;
#pragma unroll 1
    for (int half = 0; half < 2; ++half) {
        f32x4 v[8];
#pragma unroll
        for (int i = 0; i < 8; ++i) v[i] = *(const f32x4*)(srcv + (size_t)(half * 512 + kr + 64 * i) * FF);
#pragma unroll
        for (int i = 0; i < 8; ++i) { const int k = half * 512 + kr + 64 * i; tile[k * 33 + 4 * c4 + 0] = v[i][0]; tile[k * 33 + 4 * c4 + 1] = v[i][1]; tile[k * 33 + 4 * c4 + 2] = v[i][2]; tile[k * 33 + 4 * c4 + 3] = v[i][3];
            pm0 = fmaxf(pm0, fabsf(v[i][0])); pm1 = fmaxf(pm1, fabsf(v[i][1])); pm2 = fmaxf(pm2, fabsf(v[i][2])); pm3 = fmaxf(pm3, fabsf(v[i][3])); }
    }
    atomicMax((unsigned*)cmax + 4 * c4, __float_as_uint(pm0)); atomicMax((unsigned*)cmax + 4 * c4 + 1, __float_as_uint(pm1)); atomicMax((unsigned*)cmax + 4 * c4 + 2, __float_as_uint(pm2)); atomicMax((unsigned*)cmax + 4 * c4 + 3, __float_as_uint(pm3));
    __syncthreads();
    if (F.tid < 32) scl[n0 + F.tid] = __uint_as_float(cmax[F.tid]) * (1.0f / 127.0f);
    { const int n = F.tid & 31, kc0 = F.tid >> 5; const float m = __uint_as_float(cmax[n]); const float iv = m > 0.f ? 127.0f / m : 0.f;
#pragma unroll
      for (int i = 0; i < 4; ++i) { const int k16 = (kc0 + 16 * i) * 16; unsigned w[4];
#pragma unroll
          for (int j = 0; j < 4; ++j) { f32x4 q; q[0] = rintf(tile[(k16 + 4 * j) * 33 + n] * iv); q[1] = rintf(tile[(k16 + 4 * j + 1) * 33 + n] * iv); q[2] = rintf(tile[(k16 + 4 * j + 2) * 33 + n] * iv); q[3] = rintf(tile[(k16 + 4 * j + 3) * 33 + n] * iv); w[j] = pack_i8x4(q); }
          *(u32x4*)(dst + (size_t)(n0 + n) * 1024 + k16) = (u32x4){w[0], w[1], w[2], w[3]}; } }
    __syncthreads();
}
__device__ __forceinline__ void convert_moe_layer(const Frame& F, LAS unsigned char* lds, int mi) {
    LAS float* tile = (LAS float*)lds;
    constexpr int TGU = 5632 / 32;
    for (int u = F.bid; u < NE * TGU; u += F.G) {
        const int e = u / TGU, r = u % TGU; const size_t so = ((size_t)mi * NE + e) * 1024 * FF;
        convert_unit_gu32(F, tile, F.in[36] + so, F.in[37] + so, WSP(signed char, WS_MGU) + (size_t)e * 5632 * 1024, WSP(float, WS_MGUS) + e * 5632, r * 32);
    }
    for (int u = F.bid; u < NE * 16; u += F.G) {
        const int e = u >> 4, r2 = u & 15; const size_t so = ((size_t)mi * NE + e) * 1024 * FF;
        convert_unit_i8<3, 1, FF>(F, tile, F.in[38] + so, nullptr, 1024, WSP(signed char, WS_MD) + (size_t)e * 1024 * FF, WSP(float, WS_MDS) + e * 1024, r2 * 64);
    }
}

__device__ __forceinline__ void ph_mods(const Frame& F, LAS unsigned char* lds) {
    LAS float* act = (LAS float*)lds;
    LAS float* part = act + 17 * 1024;
    for (int i = F.tid; i < 17 * 1024; i += 512) { const int r = i >> 10, k = i & 1023; const float v = r < 16 ? F.in[1][r * 1024 + k] : F.in[3][k]; act[i] = silu(v); }
    __syncthreads();
    for (int u = F.bid; u < 4 * 48; u += F.G) {
        const int l = u / 48, n0 = (u % 48) * 128, nl = F.tid & 63, kq = F.tid >> 6;
        const float* w = F.in[4] + (size_t)l * 1024 * 6144 + n0 + nl;
        float a[17], c[17];
#pragma unroll
        for (int r = 0; r < 17; ++r) { a[r] = 0.f; c[r] = 0.f; }
#pragma unroll 1
        for (int k = kq * 128; k < kq * 128 + 128; k += 8) {
            float wv[8], wu[8];
#pragma unroll
            for (int j = 0; j < 8; ++j) { wv[j] = w[(size_t)(k + j) * 6144]; wu[j] = w[(size_t)(k + j) * 6144 + 64]; }
#pragma unroll
            for (int r = 0; r < 17; ++r) { const f32x4 a0 = *(const LAS f32x4*)(act + r * 1024 + k), a1 = *(const LAS f32x4*)(act + r * 1024 + k + 4);
                a[r] += (a0[0] * wv[0] + a0[1] * wv[1]) + (a0[2] * wv[2] + a0[3] * wv[3]) + (a1[0] * wv[4] + a1[1] * wv[5]) + (a1[2] * wv[6] + a1[3] * wv[7]);
                c[r] += (a0[0] * wu[0] + a0[1] * wu[1]) + (a0[2] * wu[2] + a0[3] * wu[3]) + (a1[0] * wu[4] + a1[1] * wu[5]) + (a1[2] * wu[6] + a1[3] * wu[7]); }
        }
#pragma unroll
        for (int r = 0; r < 17; ++r) { part[(kq * 17 + r) * 128 + nl] = a[r]; part[(kq * 17 + r) * 128 + 64 + nl] = c[r]; }
        __syncthreads();
        for (int i = F.tid; i < 17 * 128; i += 512) { const int r = i >> 7, n = i & 127; float sacc = F.in[5][l * 6144 + n0 + n];
#pragma unroll
            for (int q = 0; q < 8; ++q) sacc += part[(q * 17 + r) * 128 + n];
            WSP(float, WS_MOD)[((size_t)l * 17 + r) * 6144 + n0 + n] = sacc; }
        __syncthreads();
    }
}
__device__ __forceinline__ void ph_tables(const Frame& F) {
    if (F.bid != (F.G > 100 ? 100 : 0)) return;
    float* tda = WSP(float, WS_ROPE_DA); float* tml = WSP(float, WS_ROPE_ML);
    for (int i = F.tid; i < 64 * 12; i += 512) { const int pos = i / 12, f = i % 12; const float inv = fast_exp2(-(float)(2 * f) / 24.0f * 13.287712379549449f); const float ang = (float)pos * inv; tda[2 * i] = fast_cos(ang); tda[2 * i + 1] = fast_sin(ang); }
    for (int i = F.tid; i < 64 * 8; i += 512) { const int pos = i / 8, f = i % 8; const float inv = fast_exp2(-(float)(2 * f) / 16.0f * 13.287712379549449f); const float ang = (float)pos * inv; tml[2 * i] = fast_cos(ang); tml[2 * i + 1] = fast_sin(ang); }
    if (F.tid < 4) { const int l = F.tid; float s1 = 0.f, s2 = 0.f;
        for (int i = 0; i < 48; ++i) { s1 += F.in[7][l * 48 + i] * F.in[8][l * 48 + i]; s2 += F.in[9][l * 48 + i] * F.in[10][l * 48 + i]; }
        WSP(float, WS_LAM)[l] = fast_exp(s1) - fast_exp(s2) + (0.8f - 0.6f * fast_exp(-0.3f * (float)l)); }
}
__device__ __forceinline__ void ph_filters(const Frame& F, LAS unsigned char* lds) {
    LAS float* zf = (LAS float*)lds;
    LAS float* h1 = zf + 8 * 33;
    LAS float* h2 = h1 + 8 * 64;
    LAS float* h3 = h2 + 8 * 64;
    const int NU = 4 * (256 + 32);
    for (int u = F.bid; u < NU; u += F.G) {
        const int l = u / 288, r = u % 288; const int n = r < 256 ? 2048 : 256; const int i0 = (r < 256 ? r : r - 256) * 8;
        if (F.tid < 8 * 33) { const int p = F.tid / 33, k = F.tid % 33; const int i = i0 + p; float v;
            if (k == 0) v = (float)i / (float)(n - 1);
            else { const int band = (k - 1) & 15; const float f = 1e-4f + (float)band * ((15.0f - 1e-4f) / 15.0f); const float w = 6.283185307179586f * (float)i / (float)n;
                   v = k <= 16 ? fast_cos(f * w) : -fast_sin(f * w); }
            zf[F.tid] = v; }
        __syncthreads();
        { const int p = F.tid >> 6, j = F.tid & 63; const float fr = F.in[21][l * 64 + j];
          float s = F.in[15][l * 64 + j]; for (int k = 0; k < 33; ++k) s += zf[p * 33 + k] * F.in[14][(l * 33 + k) * 64 + j];
          h1[p * 64 + j] = fast_sin(fr * s); __syncthreads();
          s = F.in[17][l * 64 + j]; for (int k = 0; k < 64; ++k) s += h1[p * 64 + k] * F.in[16][(l * 64 + k) * 64 + j];
          h2[p * 64 + j] = fast_sin(fr * s); __syncthreads();
          s = F.in[19][l * 64 + j]; for (int k = 0; k < 64; ++k) s += h2[p * 64 + k] * F.in[18][(l * 64 + k) * 64 + j];
          h3[p * 64 + j] = fast_sin(fr * s); __syncthreads(); }
        bf16_t* HF = n == 2048 ? WSP(bf16_t, WS_HF) + (size_t)l * 2 * 256 * 4096 : WSP(bf16_t, WS_HFC) + (size_t)l * 2 * 256 * 512;
#pragma unroll
        for (int cc = 0; cc < 2; ++cc) {
            const int col = F.tid + 512 * cc; float a[8];
#pragma unroll
            for (int p = 0; p < 8; ++p) a[p] = 0.f;
            for (int k = 0; k < 64; ++k) { const float wv = F.in[20][((size_t)l * 64 + k) * 1024 + col];
#pragma unroll
                for (int p = 0; p < 8; ++p) a[p] += h3[p * 64 + k] * wv; }
            const int dir = col >> 9, ord = (col >> 8) & 1, ch = col & 255;
            const float delta = 3.0701134573253944f + (15.350567286626972f - 3.0701134573253944f) * (float)ch / 255.0f;
            bf16_t* row = HF + ((size_t)ord * 256 + ch) * (2 * n);
#pragma unroll
            for (int p = 0; p < 8; ++p) { const int i = i0 + p; const float t = (float)i / (float)(n - 1); a[p] *= (fast_exp(-t * delta) + 0.05f); if (dir == 1 && i == 0) a[p] = 0.f; }
            u32x4 wv; wv.x = cvt_pk_bf16(a[0], a[1]); wv.y = cvt_pk_bf16(a[2], a[3]); wv.z = cvt_pk_bf16(a[4], a[5]); wv.w = cvt_pk_bf16(a[6], a[7]);
            *(u32x4*)(row + dir * n + i0) = wv;
        }
        __syncthreads();
    }
}

__device__ __forceinline__ void load_vec4(f32x4 (&v)[4], const float* p, int lane) {
#pragma unroll
    for (int i = 0; i < 2; ++i)
#pragma unroll
        for (int k = 0; k < 2; ++k) v[2 * i + k] = *(const f32x4*)(p + 8 * lane + 512 * i + 4 * k);
}
__device__ __forceinline__ void load_row_raw(u32x4 (&h)[2], const bf16_t* row, int lane) {
#pragma unroll
    for (int i = 0; i < 2; ++i) h[i] = *(const u32x4*)(row + 8 * lane + 512 * i);
}
__device__ __forceinline__ void unpack_row_f16(f32x4 (&x)[4], const u32x4 (&hh)[2]) {
#pragma unroll
    for (int i = 0; i < 2; ++i) { const u32x4 h = hh[i]; const f32x2 a0 = unpk_f16(h.x), a1 = unpk_f16(h.y), a2 = unpk_f16(h.z), a3 = unpk_f16(h.w);
        x[2 * i] = (f32x4){a0[0], a0[1], a1[0], a1[1]}; x[2 * i + 1] = (f32x4){a2[0], a2[1], a3[0], a3[1]}; }
}
__device__ __forceinline__ void store_row_f16(bf16_t* row, int lane, const f32x4 (&x)[4]) {
#pragma unroll
    for (int i = 0; i < 2; ++i) { u32x4 w; w.x = cvt_pk_f16(x[2 * i][0], x[2 * i][1]); w.y = cvt_pk_f16(x[2 * i][2], x[2 * i][3]); w.z = cvt_pk_f16(x[2 * i + 1][0], x[2 * i + 1][1]); w.w = cvt_pk_f16(x[2 * i + 1][2], x[2 * i + 1][3]);
        *(u32x4*)(row + 8 * lane + 512 * i) = w; }
}
__device__ __forceinline__ void store_hmod(signed char* H, float* HS, size_t R, int lane, const f32x4 (&x)[4], const f32x4 (&msh)[4], const f32x4 (&msc)[4]) {
    f32x4 h[4]; float am = 0.f;
#pragma unroll
    for (int i = 0; i < 4; ++i) { const f32x4 sh = msh[i], sc = msc[i];
        h[i] = x[i] * (sc + 1.0f) + sh; am = fmaxf(am, fmaxf(fmaxf(fabsf(h[i][0]), fabsf(h[i][1])), fmaxf(fabsf(h[i][2]), fabsf(h[i][3])))); }
    am = wave_max_nonneg(am);
    const float inv = am > 0.f ? 127.0f / am : 0.f;
#pragma unroll
    for (int i = 0; i < 2; ++i) { u32x2 w;
#pragma unroll
        for (int k = 0; k < 2; ++k) { const f32x4 hh = h[2 * i + k]; f32x4 q; q[0] = rintf(hh[0] * inv); q[1] = rintf(hh[1] * inv); q[2] = rintf(hh[2] * inv); q[3] = rintf(hh[3] * inv); if (k == 0) w.x = pack_i8x4(q); else w.y = pack_i8x4(q); }
        *(u32x2*)(H + R * 1024 + 8 * lane + 512 * i) = w; }
    if (lane == 0) HS[R] = am * (1.0f / 127.0f);
}
__device__ __forceinline__ void layer_norm_row(f32x4 (&x)[4], int lane, const f32x4 (&g)[4], const f32x4 (&b)[4]) {
    float s = 0.f;
#pragma unroll
    for (int i = 0; i < 4; ++i) s += (x[i][0] + x[i][1]) + (x[i][2] + x[i][3]);
    const float mu = wave_sum(s, lane) * (1.0f / 1024.0f); float q = 0.f;
#pragma unroll
    for (int i = 0; i < 4; ++i) { const f32x4 d = x[i] - mu; q += (d[0] * d[0] + d[1] * d[1]) + (d[2] * d[2] + d[3] * d[3]); }
    const float rstd = __builtin_amdgcn_rsqf(wave_sum(q, lane) * (1.0f / 1024.0f) + LN_EPS);
#pragma unroll
    for (int i = 0; i < 4; ++i) x[i] = (x[i] - mu) * rstd * g[i] + b[i];
}
__device__ __forceinline__ void ph_init(const Frame& F) {
    signed char* H = WSP(signed char, WS_HMOD); float* HS = WSP(float, WS_HSC); const float* mod = WSP(float, WS_MOD);
    const int rpw = (MR + F.G * 8 - 1) / (F.G * 8); const int R0 = (F.bid * 8 + F.wid) * rpw; int key = -1; f32x4 msh[4], msc[4];
    for (int R = R0; R < R0 + rpw && R < MR; ++R) {
        const int b = R / TPB, j = R % TPB; const float* src = j < CTXL ? F.in[2] + ((size_t)b * CTXL + j) * 1024 : F.in[0] + ((size_t)b * SEQ + (j - CTXL)) * 1024;
        const float* mr = mod + (size_t)(j < CTXL ? 16 : b) * 6144;
        f32x4 x[4];
#pragma unroll
        for (int i = 0; i < 4; ++i) x[i] = *(const f32x4*)(src + 8 * F.lane + 512 * (i >> 1) + 4 * (i & 1));
        { const int k2 = j < CTXL ? 16 : b; if (k2 != key) { key = k2; load_vec4(msh, mr, F.lane); load_vec4(msc, mr + 1024, F.lane); } }
        store_hmod(H, HS, R, F.lane, x, msh, msc);
    }
}
__device__ __forceinline__ void ph_ln1(const Frame& F, LAS unsigned char* lds, int layer, bool latent_only) {
    const bf16_t* YH = WSP(bf16_t, WS_YH); bf16_t* XH = WSP(bf16_t, WS_XH); signed char* H = WSP(signed char, WS_HMOD); float* HS = WSP(float, WS_HSC); const float* mod = WSP(float, WS_MOD) + (size_t)layer * 17 * 6144;
    const float* g = F.in[28] + layer * 1024; const float* bb = F.in[29] + layer * 1024;
    const bool moe = layer & 1; const int mi = layer >> 1;
    LAS float* rw = (LAS float*)lds;
    LAS unsigned* lcnt = (LAS unsigned*)(lds + 32768);
    LAS int* lrec = (LAS int*)(lds + 32768 + 64);
    LAS unsigned* nrec = (LAS unsigned*)(lds + 32768 + 64 + 160 * 20);
    if (moe) {
        for (int i = F.tid; i < 8 * 1024; i += 512) { const int e = i >> 10, k = i & 1023; rw[i] = F.in[35][((size_t)mi * 1024 + k) * 8 + e]; }
        if (F.tid < 16) lcnt[F.tid] = 0u; if (F.tid == 0) *nrec = 0u;
        __syncthreads();
    }
    const int nrows = latent_only ? NB * SEQ : MR;
    f32x4 gv[4], bv[4], msh[4], msc[4]; load_vec4(gv, g, F.lane); load_vec4(bv, bb, F.lane); int key = -1;
    const int rpw = (nrows + F.G * 8 - 1) / (F.G * 8); const int q0 = (F.bid * 8 + F.wid) * rpw;
    const int qend = q0 + rpw < nrows ? q0 + rpw : nrows;
    u32x4 cur[2] = {{0u, 0u, 0u, 0u}, {0u, 0u, 0u, 0u}};
    if (q0 < qend) { const int R = latent_only ? (q0 / SEQ) * TPB + CTXL + (q0 % SEQ) : q0; load_row_raw(cur, YH + (size_t)R * 1024, F.lane); }
    for (int q = q0; q < qend; ++q) {
        const int R = latent_only ? (q / SEQ) * TPB + CTXL + (q % SEQ) : q;
        u32x4 nx[2] = {cur[0], cur[1]};
        if (q + 1 < qend) { const int Rn = latent_only ? ((q + 1) / SEQ) * TPB + CTXL + ((q + 1) % SEQ) : q + 1; load_row_raw(nx, YH + (size_t)Rn * 1024, F.lane); }
        __builtin_amdgcn_sched_barrier(0);
        const int b = R / TPB, j = R % TPB; const float* mr = mod + (size_t)(j < CTXL ? 16 : b) * 6144;
        { const int k2 = j < CTXL ? 16 : b; if (k2 != key) { key = k2; load_vec4(msh, mr + 3 * 1024, F.lane); load_vec4(msc, mr + 4 * 1024, F.lane); } }
        f32x4 x[4];
        unpack_row_f16(x, cur); cur[0] = nx[0]; cur[1] = nx[1];
        layer_norm_row(x, F.lane, gv, bv);
        if (!moe) store_row_f16(XH + (size_t)R * 1024, F.lane, x);
        store_hmod(H, HS, R, F.lane, x, msh, msc);
        if (moe) {
            float lg[8];
#pragma unroll
            for (int e = 0; e < 8; ++e) lg[e] = 0.f;
#pragma unroll
            for (int i = 0; i < 4; ++i) { const int c = 8 * F.lane + 512 * (i >> 1) + 4 * (i & 1); const f32x4 sh = msh[i], sc = msc[i];
                const f32x4 h = x[i] * (sc + 1.0f) + sh;
#pragma unroll
                for (int e = 0; e < 8; ++e) { const f32x4 w = *(const LAS f32x4*)(rw + e * 1024 + c); lg[e] += (h[0] * w[0] + h[1] * w[1]) + (h[2] * w[2] + h[3] * w[3]); } }
#pragma unroll
            for (int e = 0; e < 8; ++e) lg[e] = wave_sum(lg[e], F.lane);
            if (F.lane == 0) {
                int e0 = 0; float l0 = lg[0];
#pragma unroll
                for (int e = 1; e < 8; ++e) if (lg[e] > l0) { l0 = lg[e]; e0 = e; }
                int e1 = -1; float l1 = -3.0e38f;
#pragma unroll
                for (int e = 0; e < 8; ++e) if (e != e0 && lg[e] > l1) { l1 = lg[e]; e1 = e; }
                const float g1 = 1.0f / (1.0f + fast_exp(l0 - l1)); const float g0 = 1.0f - g1;
                WSP(f32x2, WS_MGATE)[R] = (f32x2){g0, g1};
                const unsigned s0 = atomicAdd((unsigned*)lcnt + e0, 1u), s1 = atomicAdd((unsigned*)lcnt + e1, 1u);
                const unsigned ri = atomicAdd((unsigned*)nrec, 1u);
                lrec[ri * 5 + 0] = R; lrec[ri * 5 + 1] = e0; lrec[ri * 5 + 2] = e1; lrec[ri * 5 + 3] = (int)s0; lrec[ri * 5 + 4] = (int)s1;
            }
        }
    }
    if (moe) {
        __syncthreads();
        if (F.tid < 8) lcnt[8 + F.tid] = lcnt[F.tid] ? __hip_atomic_fetch_add(F.ctl + CW_MCNT + (mi * 8 + F.tid) * 64, lcnt[F.tid], __ATOMIC_RELAXED, __HIP_MEMORY_SCOPE_AGENT) : 0u;
        __syncthreads();
        const unsigned nr = *nrec;
        for (unsigned i = F.tid; i < nr; i += 512) { const int R = lrec[i * 5], e0 = lrec[i * 5 + 1], e1 = lrec[i * 5 + 2];
            int4 v; v.x = e0; v.y = e1; v.z = (int)lcnt[8 + e0] + lrec[i * 5 + 3]; v.w = (int)lcnt[8 + e1] + lrec[i * 5 + 4]; WSP(int4, WS_MASG)[R] = v; }
    }
}
__device__ __forceinline__ void ph_gather(const Frame& F, LAS unsigned char* lds, int layer, bool latent_only) {
    const int mi = layer >> 1; LAS int* ps = (LAS int*)lds;
    if (F.tid == 0) { int acc = 0; for (int e = 0; e < 8; ++e) { const int c = (int)__hip_atomic_load(F.ctl + CW_MCNT + (mi * 8 + e) * 64, __ATOMIC_RELAXED, __HIP_MEMORY_SCOPE_AGENT); ps[e] = acc; ps[8 + e] = c; acc += (c + 255) / 256 * 256; } ps[16] = acc; }
    __syncthreads();
    unsigned* mt = F.ctl + CW_MTILE + mi * 512;
    if (F.bid == 0) { const int nt = ps[16] / 256; if (F.tid == 0) mt[0] = (unsigned)nt;
        for (int t = F.tid; t < nt; t += 512) { int e = 0;
#pragma unroll
            for (int k = 1; k < 8; ++k) if (t * 256 >= ps[k]) e = k;
            mt[1 + t] = (unsigned)e; } }
    signed char* rows = WSP(signed char, WS_ROWS8); const signed char* H = WSP(signed char, WS_HMOD); float* rsc = WSP(float, WS_RSC); const float* HS = WSP(float, WS_HSC);
    const int nrows = latent_only ? NB * SEQ : MR;
    for (int q0 = (F.bid * 8 + F.wid) * 8; q0 < nrows; q0 += F.G * 8 * 8) {
        int Rv[8]; int4 av[8]; u32x4 vv[8]; float sv[8];
#pragma unroll
        for (int t = 0; t < 8; ++t) { const int q = q0 + t; Rv[t] = latent_only ? (q / SEQ) * TPB + CTXL + (q % SEQ) : q; av[t] = WSP(int4, WS_MASG)[Rv[t]]; vv[t] = *(const u32x4*)(H + (size_t)Rv[t] * 1024 + F.lane * 16); sv[t] = HS[Rv[t]]; }
#pragma unroll
        for (int t = 0; t < 8; ++t) { int4 a = av[t]; const int d0 = ps[a.x] + a.z, d1 = ps[a.y] + a.w;
            *(u32x4*)(rows + (size_t)d0 * 1024 + F.lane * 16) = vv[t]; *(u32x4*)(rows + (size_t)d1 * 1024 + F.lane * 16) = vv[t];
            if (F.lane == 0) { a.z = d0; a.w = d1; WSP(int4, WS_MASG)[Rv[t]] = a; rsc[d0] = sv[t]; rsc[d1] = sv[t]; } }
    }
    for (int q = F.bid * 8 + F.wid; q < 8 * 256; q += F.G * 8) { const int e = q >> 8, r = q & 255; const int c = ps[8 + e]; const int pc = (c + 255) / 256 * 256;
        if (c + r < pc) { const size_t d = (size_t)(ps[e] + c + r); unsigned zz = 0u; asm volatile("" : "+v"(zz)); const u32x4 z = {zz, zz, zz, zz}; *(u32x4*)(rows + d * 1024 + F.lane * 16) = z; if (F.lane == 0) rsc[d] = 0.f; } }
}
__device__ __forceinline__ void ph_ln2(const Frame& F, int layer, bool latent_only) {
    const bf16_t* YH = WSP(bf16_t, WS_YH); bf16_t* XH = WSP(bf16_t, WS_XH); signed char* H = WSP(signed char, WS_HMOD); float* HS = WSP(float, WS_HSC); const float* mod = WSP(float, WS_MOD) + (size_t)layer * 17 * 6144;
    const float* g = F.in[30] + layer * 1024; const float* bb = F.in[31] + layer * 1024;
    const bool moe = layer & 1; const bf16_t* OE = WSP(bf16_t, WS_ROWS);
    const int nrows = latent_only ? NB * SEQ : MR;
    f32x4 gv[4], bv[4], msh[4], msc[4], g2v[4]; load_vec4(gv, g, F.lane); load_vec4(bv, bb, F.lane); int key = -1;
    const int rpw = (nrows + F.G * 8 - 1) / (F.G * 8); const int q0 = (F.bid * 8 + F.wid) * rpw;
    const int qend = q0 + rpw < nrows ? q0 + rpw : nrows;
    const bf16_t* SRC = YH;
    f32x4 g1v[4], b1v[4]; if (moe) { load_vec4(g1v, F.in[28] + layer * 1024, F.lane); load_vec4(b1v, F.in[29] + layer * 1024, F.lane); }
    u32x4 cur[2] = {{0u, 0u, 0u, 0u}, {0u, 0u, 0u, 0u}}; int4 a = {0, 0, 0, 0}; f32x2 gt = {0.f, 0.f};
    if (q0 < qend) { const int R = latent_only ? (q0 / SEQ) * TPB + CTXL + (q0 % SEQ) : q0; load_row_raw(cur, SRC + (size_t)R * 1024, F.lane); if (moe) { a = WSP(int4, WS_MASG)[R]; gt = WSP(f32x2, WS_MGATE)[R]; } }
    for (int q = q0; q < qend; ++q) {
        const int R = latent_only ? (q / SEQ) * TPB + CTXL + (q % SEQ) : q;
        u32x4 oe[2][2] = {{{0u, 0u, 0u, 0u}, {0u, 0u, 0u, 0u}}, {{0u, 0u, 0u, 0u}, {0u, 0u, 0u, 0u}}};
        if (moe) {
#pragma unroll
            for (int i = 0; i < 2; ++i) { const int c = 8 * F.lane + 512 * i; oe[i][0] = *(const u32x4*)(OE + (size_t)a.z * 1024 + c); oe[i][1] = *(const u32x4*)(OE + (size_t)a.w * 1024 + c); } }
        u32x4 nx[2] = {cur[0], cur[1]}; int4 an = a; f32x2 gn = gt;
        if (q + 1 < qend) { const int Rn = latent_only ? ((q + 1) / SEQ) * TPB + CTXL + ((q + 1) % SEQ) : q + 1; load_row_raw(nx, SRC + (size_t)Rn * 1024, F.lane); if (moe) { an = WSP(int4, WS_MASG)[Rn]; gn = WSP(f32x2, WS_MGATE)[Rn]; } }
        __builtin_amdgcn_sched_barrier(0);
        const int b = R / TPB, j = R % TPB; const float* mr = mod + (size_t)(j < CTXL ? 16 : b) * 6144;
        { const int k2 = j < CTXL ? 16 : b; if (k2 != key) { key = k2; if (moe) load_vec4(g2v, mr + 5 * 1024, F.lane);
            if (layer != DEPTH - 1) { load_vec4(msh, mr + 17 * 6144, F.lane); load_vec4(msc, mr + 17 * 6144 + 1024, F.lane); } } }
        f32x4 x[4];
        unpack_row_f16(x, cur); cur[0] = nx[0]; cur[1] = nx[1];
        if (moe) {
            layer_norm_row(x, F.lane, g1v, b1v);
            const f32x2 gtc = gt; a = an; gt = gn;
#pragma unroll
            for (int i = 0; i < 2; ++i) {
                const u32x4 o0 = oe[i][0], o1 = oe[i][1];
                f32x4 f; f[0] = gtc[0] * bflo(o0.x) + gtc[1] * bflo(o1.x); f[1] = gtc[0] * bfhi(o0.x) + gtc[1] * bfhi(o1.x); f[2] = gtc[0] * bflo(o0.y) + gtc[1] * bflo(o1.y); f[3] = gtc[0] * bfhi(o0.y) + gtc[1] * bfhi(o1.y);
                x[2 * i] = x[2 * i] * ALPHA + g2v[2 * i] * f;
                f[0] = gtc[0] * bflo(o0.z) + gtc[1] * bflo(o1.z); f[1] = gtc[0] * bfhi(o0.z) + gtc[1] * bfhi(o1.z); f[2] = gtc[0] * bflo(o0.w) + gtc[1] * bflo(o1.w); f[3] = gtc[0] * bfhi(o0.w) + gtc[1] * bfhi(o1.w);
                x[2 * i + 1] = x[2 * i + 1] * ALPHA + g2v[2 * i + 1] * f; }
        }
        layer_norm_row(x, F.lane, gv, bv);
        if (layer == DEPTH - 1) {
            float* o = F.out + ((size_t)b * SEQ + (j - CTXL)) * 1024;
#pragma unroll
            for (int i = 0; i < 4; ++i) *(f32x4*)(o + 8 * F.lane + 512 * (i >> 1) + 4 * (i & 1)) = x[i];
        } else {
            store_row_f16(XH + (size_t)R * 1024, F.lane, x);
            store_hmod(H, HS, R, F.lane, x, msh, msc);
        }
    }
}

__device__ __forceinline__ void ph_post(const Frame& F, LAS unsigned char* lds, int layer, bool need_ctx) {
    const bf16_t* P = WSP(bf16_t, WS_PROJ); bf16_t* CQ = WSP(bf16_t, WS_CQN); bf16_t* CKV = WSP(bf16_t, WS_CKVN);
    for (int R0 = (F.bid * 8 + F.wid) * 4; R0 < MR; R0 += F.G * 8 * 4) {
        u32x2 av[4]; unsigned kv[4];
#pragma unroll
        for (int q = 0; q < 4; ++q) { const size_t R = (size_t)(R0 + q); av[q] = *(const u32x2*)(P + R * PLD + C_CQ + 4 * F.lane); kv[q] = *(const unsigned*)(P + R * PLD + C_CKV + 2 * F.lane); }
#pragma unroll
        for (int q = 0; q < 4; ++q) { const size_t R = (size_t)(R0 + q);
            const float a0 = bflo(av[q].x), a1 = bfhi(av[q].x), a2 = bflo(av[q].y), a3 = bfhi(av[q].y);
            const float rs = __builtin_amdgcn_rsqf(wave_sum((a0 * a0 + a1 * a1) + (a2 * a2 + a3 * a3), F.lane) * (1.0f / 256.0f) + RMS_EPS);
            u32x2 w; w.x = cvt_pk_bf16(a0 * rs, a1 * rs); w.y = cvt_pk_bf16(a2 * rs, a3 * rs); *(u32x2*)(CQ + R * 256 + 4 * F.lane) = w;
            const float k0 = bflo(kv[q]), k1 = bfhi(kv[q]);
            const float rk = __builtin_amdgcn_rsqf(wave_sum(k0 * k0 + k1 * k1, F.lane) * (1.0f / 128.0f) + RMS_EPS);
            *(unsigned*)(CKV + R * 256 + 2 * F.lane) = cvt_pk_bf16(k0 * rk, k1 * rk);
            *(unsigned*)(CKV + R * 256 + 128 + 2 * F.lane) = 0u; }
    }
}
__device__ __forceinline__ void ph_conv(LAS unsigned char* lds, int layer, bool need_ctx) {
    const Frame F = make_frame(); const bf16_t* P = WSP(bf16_t, WS_PROJ);
    LAS bf16_t* pt = (LAS bf16_t*)lds;
    LAS bf16_t* ot = (LAS bf16_t*)(lds + 66 * 256 * 2);
    const int NUL = 16 * 32 * 3, NUC = need_ctx ? 16 * 4 * 3 : 0;
#define CONV_LOAD(uq, dstv) do { const bool isc_ = (uq) >= NUL; const int uu_ = isc_ ? (uq) - NUL : (uq); const int n_ = isc_ ? CTXL : SEQ; const int ntt_ = n_ / 64; \
        const int cc_ = uu_ % 3, tt_ = (uu_ / 3) % ntt_, b_ = uu_ / (3 * ntt_); const size_t rb_ = (size_t)b_ * TPB + (isc_ ? 0 : CTXL); \
        _Pragma("unroll") for (int i = 0; i < 5; ++i) { const int id = F.tid + 512 * i; dstv[i] = (u32x4){0u, 0u, 0u, 0u}; if (id < 66 * 32) { const int rr = id >> 5, ch = id & 31; const int t = tt_ * 64 - 1 + rr; \
            if (t >= 0 && t < n_) dstv[i] = *(const u32x4*)(P + (rb_ + t) * PLD + C_HY + cc_ * 256 + ch * 8); } } } while (0)
    const int NU = NUL + NUC, per_low = NU / 288; const bool low = F.bid < 176 || F.G != 256;
    int u, ustep, uend;
    if (F.G != 256) { u = F.bid; ustep = F.G; uend = NU; }
    else if (low) { u = F.bid * per_low; ustep = 1; uend = u + per_low; }
    else { u = 176 * per_low + (F.bid - 176); ustep = 80; uend = NU; }
    u32x4 pre[5];
    if (u < uend) CONV_LOAD(u, pre);
#pragma unroll 1
    while (u < uend) {
        const int un = u + ustep < uend ? u + ustep : NU;
        const bool isc = u >= NUL; const int uu = isc ? u - NUL : u; const int n = isc ? CTXL : SEQ; const int ntt = n / 64;
        const int cc = uu % 3, tt = (uu / 3) % ntt, b = uu / (3 * ntt); const int t0 = tt * 64, c0 = cc * 256;
#pragma unroll
        for (int i = 0; i < 5; ++i) { const int id = F.tid + 512 * i; if (id < 66 * 32) { const int rr = id >> 5, ch = id & 31; *(LAS u32x4*)(pt + rr * 256 + ch * 8) = pre[i]; } }
        if (un < NUL + NUC) CONV_LOAD(un, pre);
        __syncthreads();
        { const int c = F.tid & 255, th = F.tid >> 8; const float* cw = F.in[12] + (size_t)layer * 3 * 768 + c0 + c;
          const float w0 = cw[0], w1 = cw[768], w2 = cw[1536], bs = F.in[13][layer * 768 + c0 + c];
          float pa = bf2f(pt[(th * 32) * 256 + c]), pb = bf2f(pt[(th * 32 + 1) * 256 + c]);
#pragma unroll
          for (int e = 0; e < 32; e += 2) { const int ta = th * 32 + e; const float pc = bf2f(pt[(ta + 2) * 256 + c]), pd = bf2f(pt[(ta + 3) * 256 + c]);
              const float v0 = w0 * pa + w1 * pb + w2 * pc + bs, v1 = w0 * pb + w1 * pc + w2 * pd + bs;
              *(LAS unsigned*)(ot + c * 72 + ta) = cvt_pk_bf16(v0, v1); pa = pc; pb = pd; } }
        __syncthreads();
#pragma unroll
        for (int i = 0; i < 4; ++i) { const int id = F.tid + 512 * i; const int c = id >> 3, t8 = (id & 7) * 8;
          bf16_t* dst = (isc ? WSP(bf16_t, WS_UTC) : WSP(bf16_t, WS_UT)) + ((size_t)(c0 + c) * 16 + b) * n + t0 + t8;
          *(u32x4*)dst = *(const LAS u32x4*)(ot + c * 72 + t8); }
        __syncthreads();
            u = un;
    }
#undef CONV_LOAD
}
__device__ __forceinline__ void hyt_unit(const Frame& F, LAS unsigned char* lds, const bool isc, const int uu) {
    LAS bf16_t* tt_ = (LAS bf16_t*)lds;
    bf16_t* MIXB = WSP(bf16_t, WS_MIX);
    {
        const int n = isc ? CTXL : SEQ; const int ntt = n / 64; const int b = uu / ntt, t0 = (uu % ntt) * 64;
        const bf16_t* src = isc ? WSP(bf16_t, WS_HYTC) : WSP(bf16_t, WS_HYT);
        { const int c = F.tid & 255, th = F.tid >> 8;
#pragma unroll
          for (int i = 0; i < 4; ++i) { const int tc = th * 4 + i; const u32x4 v = *(const u32x4*)(src + ((size_t)c * 16 + b) * n + t0 + tc * 8);
              tt_[(tc * 8 + 0) * 264 + c] = (bf16_t)(v.x & 0xffff); tt_[(tc * 8 + 1) * 264 + c] = (bf16_t)(v.x >> 16); tt_[(tc * 8 + 2) * 264 + c] = (bf16_t)(v.y & 0xffff); tt_[(tc * 8 + 3) * 264 + c] = (bf16_t)(v.y >> 16);
              tt_[(tc * 8 + 4) * 264 + c] = (bf16_t)(v.z & 0xffff); tt_[(tc * 8 + 5) * 264 + c] = (bf16_t)(v.z >> 16); tt_[(tc * 8 + 6) * 264 + c] = (bf16_t)(v.w & 0xffff); tt_[(tc * 8 + 7) * 264 + c] = (bf16_t)(v.w >> 16); } }
        __syncthreads();
        const size_t rbase = (size_t)b * TPB + (isc ? 0 : CTXL) + t0;
#pragma unroll
        for (int i = 0; i < 4; ++i) { const int id = F.tid + 512 * i; const int ta = id >> 5, c8 = id & 31;
            *(u32x4*)(MIXB + (rbase + ta) * 1024 + 384 + c8 * 8) = *(const LAS u32x4*)(tt_ + ta * 264 + c8 * 8); }
        __syncthreads();
    }
}
__device__ __forceinline__ void wait_count(const Frame& F, unsigned* word, unsigned want) {
    if (F.wid == 0) {
        for (unsigned spins = 0; spins < (1u << 22); ++spins) {
            if ((unsigned)__builtin_amdgcn_readfirstlane((int)__hip_atomic_load(word, __ATOMIC_RELAXED, __HIP_MEMORY_SCOPE_AGENT)) >= want) break;
            __builtin_amdgcn_s_sleep(2);
        }
        __builtin_amdgcn_fence(__ATOMIC_ACQUIRE, "agent");
    }
    __syncthreads();
}

__device__ __forceinline__ u32x4 widen_pair32(u32x2 a, u32x2 b) {
    const auto r0 = __builtin_amdgcn_permlane32_swap(a.x, b.x, false, false); const auto r1 = __builtin_amdgcn_permlane32_swap(a.y, b.y, false, false);
    return (u32x4){r0[0], r1[0], r0[1], r1[1]};
}
template <int MLA>
__device__ __forceinline__ void attn_unit(const Frame& F, LAS unsigned char* lds, int layer, int b, int h, int q0, int nkeys) {
    constexpr int NMAP = MLA ? 1 : 2, NKB = MLA ? 6 : 3, DV = MLA ? 64 : 96, NDV = DV / 32;
    constexpr int KS = 208, VS = MLA ? 144 : 208, BUF = 64 * 208 * 2;
    const float* gsub_all = F.in[11];
    const int lane = F.lane, wid = F.wid, r = lane & 31, hh = lane >> 5;
    const bf16_t* P = WSP(bf16_t, WS_PROJ); const bf16_t* MQ = WSP(bf16_t, WS_MQ); const bf16_t* MKV = WSP(bf16_t, WS_MKV);
    const size_t rowb = (size_t)b * TPB; const size_t qrow = rowb + q0 + wid * 32 + r;
    LAS float* red = (LAS float*)(lds + 2 * BUF);
    constexpr int KSL = 64 * 13, VPR = VS / 16, NINST = (KSL + 64 * VPR) / 64;
    const unsigned char* sg[4]; unsigned sstep[4];
#pragma unroll
    for (int j4 = 0; j4 < 4; ++j4) { const int j = wid + 8 * j4; const int sl = (j < NINST ? j : 0) * 64 + lane; const bf16_t* gp; bool isp;
        if (sl < KSL) { const int key = sl / 13; int cc = sl - key * 13; cc = cc >= 12 ? 0 : cc; const size_t row = rowb + key;
            if (!MLA) { gp = P + row * PLD + C_DAK + h * 96 + cc * 8; isp = true; } else if (cc < 8) { gp = MKV + row * MKVLD + h * 128 + cc * 8; isp = false; } else { gp = P + row * PLD + C_KR + (cc - 8) * 8; isp = true; } }
        else { const int s2 = sl - KSL; const int key = s2 / VPR; int cc = s2 - key * VPR; cc = cc >= VPR - 1 ? 0 : cc; const size_t row = rowb + key;
            if (!MLA) { gp = P + row * PLD + C_DAV + h * 96 + cc * 8; isp = true; } else { gp = MKV + row * MKVLD + h * 128 + 64 + cc * 8; isp = false; } }
        sg[j4] = (const unsigned char*)gp; sstep[j4] = isp ? 64u * PLD * 2u : 64u * MKVLD * 2u; }
#define ATT_STAGE(kt, bufi) do { _Pragma("unroll") for (int j4 = 0; j4 < 4; ++j4) { const int j = wid + 8 * j4; if (j < NINST) \
        __builtin_amdgcn_global_load_lds((const unsigned*)(sg[j4] + (size_t)(kt) * sstep[j4]), (LAS unsigned*)(lds + (bufi) * BUF + j * 1024), 16, 0, 0); } } while (0)
    bf16x8 qf[NMAP][NKB];
#pragma unroll
    for (int mp = 0; mp < NMAP; ++mp)
#pragma unroll
        for (int kb = 0; kb < NKB; ++kb)
            qf[mp][kb] = MLA ? *(const bf16x8*)(MQ + qrow * MQLD + h * 96 + kb * 16 + hh * 8) : *(const bf16x8*)(P + qrow * PLD + C_DAQ + h * 96 + mp * 48 + kb * 16 + hh * 8);
    ATT_STAGE(0, 0);
    unsigned* kmt = F.ctl + CW_KMAX + (((layer * 2 + MLA) * 16 + b) * 8 + h);
    if (F.tid == 0) { red[15] = __uint_as_float(__hip_atomic_load(kmt, __ATOMIC_RELAXED, __HIP_MEMORY_SCOPE_AGENT)); red[14] = 0.f; }
    __syncthreads();
    float kmax = red[15];
    __syncthreads();
    if (kmax == 0.f) {
        float best = 0.f;
        for (int key = F.tid; key < TPB; key += 512) {
            float ss[NMAP];
#pragma unroll
            for (int mp = 0; mp < NMAP; ++mp) ss[mp] = 0.f;
#pragma unroll
            for (int cc = 0; cc < 12; ++cc) {
                const bf16_t* gp; if (!MLA) gp = P + (rowb + key) * PLD + C_DAK + h * 96 + cc * 8; else gp = cc < 8 ? MKV + (rowb + key) * MKVLD + h * 128 + cc * 8 : P + (rowb + key) * PLD + C_KR + (cc - 8) * 8;
                const u32x4 v = *(const u32x4*)gp;
                const float t = (bflo(v.x) * bflo(v.x) + bfhi(v.x) * bfhi(v.x)) + (bflo(v.y) * bflo(v.y) + bfhi(v.y) * bfhi(v.y)) + (bflo(v.z) * bflo(v.z) + bfhi(v.z) * bfhi(v.z)) + (bflo(v.w) * bflo(v.w) + bfhi(v.w) * bfhi(v.w));
                ss[MLA ? 0 : cc / 6] += t;
            }
#pragma unroll
            for (int mp = 0; mp < NMAP; ++mp) best = fmaxf(best, ss[mp]);
        }
        best = fmaxf(best, shfl_x(best, lane, 32)); best = fmaxf(best, shfl_x(best, lane, 16)); best = fmaxf(best, shfl_x(best, lane, 8)); best = fmaxf(best, shfl_x(best, lane, 4)); best = fmaxf(best, shfl_x(best, lane, 2)); best = fmaxf(best, shfl_x(best, lane, 1));
        if (lane == 0) red[wid] = best;
        __syncthreads();
        float bm = red[0];
#pragma unroll
        for (int i = 1; i < 8; ++i) bm = fmaxf(bm, red[i]);
        kmax = fmaxf(__builtin_sqrtf(bm), 1e-20f);
        __syncthreads();
        if (F.tid == 0) __hip_atomic_store(kmt, __float_as_uint(kmax), __ATOMIC_RELAXED, __HIP_MEMORY_SCOPE_AGENT);
    }
    float qn = 0.f;
#pragma unroll
    for (int mp = 0; mp < NMAP; ++mp) { float sq = 0.f;
#pragma unroll
        for (int kb = 0; kb < NKB; ++kb) { const u32x4 v = __builtin_bit_cast(u32x4, qf[mp][kb]);
            sq += (bflo(v.x) * bflo(v.x) + bfhi(v.x) * bfhi(v.x)) + (bflo(v.y) * bflo(v.y) + bfhi(v.y) * bfhi(v.y)) + (bflo(v.z) * bflo(v.z) + bfhi(v.z) * bfhi(v.z)) + (bflo(v.w) * bflo(v.w) + bfhi(v.w) * bfhi(v.w)); }
        sq += shfl_x(sq, lane, 32); qn = fmaxf(qn, sq); }
    float mshift = __builtin_sqrtf(qn) * kmax * 1.0005f + 0.02f;
    const int nkt = nkeys / 64;
    if (mshift > 60.f) red[14] = 1.f;
    __syncthreads();
    const bool exact = red[14] != 0.f;
    __syncthreads();
    if (exact) {
        float mx = -3.0e38f;
        asm volatile("s_waitcnt vmcnt(0)" ::: "memory"); __syncthreads();
#pragma unroll 1
        for (int kt = 0; kt < nkt; ++kt) {
            const int buf = kt & 1;
            if (kt + 1 < nkt) ATT_STAGE(kt + 1, buf ^ 1);
            LAS unsigned char* Kb = lds + buf * BUF;
#pragma unroll
            for (int kb32 = 0; kb32 < 2; ++kb32)
#pragma unroll
                for (int mp = 0; mp < NMAP; ++mp) {
                    f32x16 s0;
#pragma unroll
                    for (int i = 0; i < 16; ++i) s0[i] = 0.f;
#pragma unroll
                    for (int kb = 0; kb < NKB; ++kb) s0 = __builtin_amdgcn_mfma_f32_32x32x16_bf16(*(const LAS bf16x8*)(Kb + (kb32 * 32 + r) * KS + (mp * 48 + kb * 16 + hh * 8) * 2), qf[mp][kb], s0, 0, 0, 0);
#pragma unroll
                    for (int i = 0; i < 16; ++i) mx = fmaxf(mx, s0[i]);
                }
            asm volatile("s_waitcnt vmcnt(0)" ::: "memory");
            __syncthreads();
        }
        mshift = fmaxf(mx, shfl_x(mx, lane, 32));
    }
    f32x16 negm;
#pragma unroll
    for (int i = 0; i < 16; ++i) negm[i] = -mshift;
    f32x16 O[NMAP][NDV]; float lrun[NMAP];
#pragma unroll
    for (int mp = 0; mp < NMAP; ++mp) { lrun[mp] = 0.f;
#pragma unroll
        for (int d = 0; d < NDV; ++d)
#pragma unroll
            for (int i = 0; i < 16; ++i) O[mp][d][i] = 0.f; }
    const int trq = (lane & 15) >> 2, trp = lane & 3, blk = (lane >> 4) & 1;
    const int vro = (4 * hh + trq) * VS + blk * 32 + trp * 8;
    if (exact) ATT_STAGE(0, 0);
    asm volatile("s_waitcnt vmcnt(0)" ::: "memory"); __syncthreads();
#pragma unroll 1
    for (int kt = 0; kt < nkt; ++kt) {
        const int buf = kt & 1;
        if (kt + 1 < nkt) ATT_STAGE(kt + 1, buf ^ 1);
        LAS unsigned char* Kb = lds + buf * BUF; LAS unsigned char* Vb = Kb + 64 * KS;
#define ATT_QK(sv, kb32, mp) do { sv = __builtin_amdgcn_mfma_f32_32x32x16_bf16(*(const LAS bf16x8*)(Kb + ((kb32) * 32 + r) * KS + ((mp) * 48 + hh * 8) * 2), qf[mp][0], negm, 0, 0, 0); \
            _Pragma("unroll") for (int kb = 1; kb < NKB; ++kb) sv = __builtin_amdgcn_mfma_f32_32x32x16_bf16(*(const LAS bf16x8*)(Kb + ((kb32) * 32 + r) * KS + ((mp) * 48 + kb * 16 + hh * 8) * 2), qf[mp][kb], sv, 0, 0, 0); } while (0)
#define ATT_EXP(sv, pfv, mp) do { _Pragma("unroll") for (int i = 0; i < 16; ++i) sv[i] = fast_exp2(sv[i]); \
            { const float t0 = add1(sv[0], sv[1]), t1 = add1(sv[2], sv[3]), t2 = add1(sv[4], sv[5]), t3 = add1(sv[6], sv[7]), t4 = add1(sv[8], sv[9]), t5 = add1(sv[10], sv[11]), t6 = add1(sv[12], sv[13]), t7 = add1(sv[14], sv[15]); \
              lrun[mp] = add1(lrun[mp], add1(add1(add1(t0, t1), add1(t2, t3)), add1(add1(t4, t5), add1(t6, t7)))); } \
            _Pragma("unroll") for (int s = 0; s < 2; ++s) { u32x4 w0; w0.x = cvt_pk_bf16(sv[8 * s + 0], sv[8 * s + 1]); w0.y = cvt_pk_bf16(sv[8 * s + 2], sv[8 * s + 3]); w0.z = cvt_pk_bf16(sv[8 * s + 4], sv[8 * s + 5]); w0.w = cvt_pk_bf16(sv[8 * s + 6], sv[8 * s + 7]); \
                pfv[s] = __builtin_bit_cast(bf16x8, w0); } } while (0)
        if (MLA) {
            f32x16 sa, sb; bf16x8 pa[2], pb[2];
            ATT_QK(sa, 0, 0); ATT_QK(sb, 1, 0);
            ATT_EXP(sa, pa, 0);
#pragma unroll
            for (int d = 0; d < NDV; ++d)
#pragma unroll
                for (int s = 0; s < 2; ++s) { LAS unsigned char* vp = Vb + (16 * s) * VS + d * 64 + vro;
                    const s16x4 t0 = __builtin_amdgcn_ds_read_tr16_b64_v4i16((LAS s16x4*)vp); const s16x4 t1 = __builtin_amdgcn_ds_read_tr16_b64_v4i16((LAS s16x4*)(vp + 8 * VS));
                    O[0][d] = __builtin_amdgcn_mfma_f32_32x32x16_bf16(__builtin_shufflevector(t0, t1, 0, 1, 2, 3, 4, 5, 6, 7), pa[s], O[0][d], 0, 0, 0); }
            ATT_EXP(sb, pb, 0);
#pragma unroll
            for (int d = 0; d < NDV; ++d)
#pragma unroll
                for (int s = 0; s < 2; ++s) { LAS unsigned char* vp = Vb + (32 + 16 * s) * VS + d * 64 + vro;
                    const s16x4 t0 = __builtin_amdgcn_ds_read_tr16_b64_v4i16((LAS s16x4*)vp); const s16x4 t1 = __builtin_amdgcn_ds_read_tr16_b64_v4i16((LAS s16x4*)(vp + 8 * VS));
                    O[0][d] = __builtin_amdgcn_mfma_f32_32x32x16_bf16(__builtin_shufflevector(t0, t1, 0, 1, 2, 3, 4, 5, 6, 7), pb[s], O[0][d], 0, 0, 0); }
        } else {
#pragma unroll
        for (int kb32 = 0; kb32 < 2; ++kb32) {
            f32x16 sa, sb; bf16x8 pf[NMAP][2];
            ATT_QK(sa, kb32, 0); ATT_QK(sb, kb32, NMAP - 1);
            ATT_EXP(sa, pf[0], 0); ATT_EXP(sb, pf[NMAP - 1], NMAP - 1);
            __builtin_amdgcn_sched_barrier(0);
#pragma unroll
            for (int d = 0; d < NDV; ++d) {
#pragma unroll
                for (int s = 0; s < 2; ++s) {
                    LAS unsigned char* vp = Vb + (kb32 * 32 + 16 * s) * VS + d * 64 + vro;
                    const s16x4 t0 = __builtin_amdgcn_ds_read_tr16_b64_v4i16((LAS s16x4*)vp);
                    const s16x4 t1 = __builtin_amdgcn_ds_read_tr16_b64_v4i16((LAS s16x4*)(vp + 8 * VS));
                    const bf16x8 av = __builtin_shufflevector(t0, t1, 0, 1, 2, 3, 4, 5, 6, 7);
#pragma unroll
                    for (int mp = 0; mp < NMAP; ++mp) O[mp][d] = __builtin_amdgcn_mfma_f32_32x32x16_bf16(av, pf[mp][s], O[mp][d], 0, 0, 0);
                }
                __builtin_amdgcn_sched_barrier(0);
            }
        }
        }
#undef ATT_QK
#undef ATT_EXP
        asm volatile("s_waitcnt vmcnt(0)" ::: "memory");
        __syncthreads();
    }
#undef ATT_STAGE
    bf16_t* MIXB = WSP(bf16_t, WS_MIX);
    float inv[NMAP];
#pragma unroll
    for (int mp = 0; mp < NMAP; ++mp) { const float lt = lrun[mp] + shfl_x(lrun[mp], lane, 32); inv[mp] = 1.0f / lt; }
    if (!MLA) {
        const float lam = WSP(float, WS_LAM)[layer]; const float li = 0.8f - 0.6f * fast_exp(-0.3f * (float)layer);
        const float c0 = inv[0], c1 = lam * inv[NMAP - 1]; float ss = 0.f;
#pragma unroll
        for (int d = 0; d < NDV; ++d)
#pragma unroll
            for (int i = 0; i < 16; ++i) { const float o = O[0][d][i] * c0 - O[NMAP - 1][d][i] * c1; O[0][d][i] = o; ss += o * o; }
        ss += shfl_x(ss, lane, 32);
        const float rs = __builtin_amdgcn_rsqf(ss * (1.0f / 96.0f) + RMS_EPS) * (1.0f - li);
        const float* gsub = gsub_all + layer * 96;
#pragma unroll
        for (int d = 0; d < NDV; ++d)
#pragma unroll
            for (int rp = 0; rp < 2; ++rp) { u32x2 w[2];
#pragma unroll
                for (int q = 0; q < 2; ++q) { const int rg = 2 * rp + q; const int dv = d * 32 + 8 * rg + 4 * hh; const f32x4 gg = *(const f32x4*)(gsub + dv);
                    w[q].x = cvt_pk_bf16(O[0][d][4 * rg] * rs * gg[0], O[0][d][4 * rg + 1] * rs * gg[1]); w[q].y = cvt_pk_bf16(O[0][d][4 * rg + 2] * rs * gg[2], O[0][d][4 * rg + 3] * rs * gg[3]); }
                *(u32x4*)(MIXB + qrow * 1024 + h * 96 + d * 32 + 16 * rp + 8 * hh) = widen_pair32(w[0], w[1]); }
    } else {
#pragma unroll
        for (int d = 0; d < NDV; ++d)
#pragma unroll
            for (int rp = 0; rp < 2; ++rp) { u32x2 w[2];
#pragma unroll
                for (int q = 0; q < 2; ++q) { const int rg = 2 * rp + q;
                    w[q].x = cvt_pk_bf16(O[0][d][4 * rg] * inv[0], O[0][d][4 * rg + 1] * inv[0]); w[q].y = cvt_pk_bf16(O[0][d][4 * rg + 2] * inv[0], O[0][d][4 * rg + 3] * inv[0]); }
                *(u32x4*)(MIXB + qrow * 1024 + 640 + h * 64 + d * 32 + 16 * rp + 8 * hh) = widen_pair32(w[0], w[1]); }
    }
    __syncthreads();
}

template <int N>
__device__ __forceinline__ void hyena_unit(const Frame& F, LAS unsigned char* lds, int layer, int c) {
    constexpr int TPW = N / 128, NSIG = N / 32, CPS = 4 * N + 16, ZS = 2 * N + 16;
    const float* hy_bias = F.in[22];
    LAS unsigned char* CP = lds; LAS unsigned char* ZT = lds + 8 * CPS;
    const bf16_t* UTb = N == SEQ ? WSP(bf16_t, WS_UT) : WSP(bf16_t, WS_UTC);
    bf16_t* OUT = N == SEQ ? WSP(bf16_t, WS_HYT) : WSP(bf16_t, WS_HYTC);
    const bf16_t* HFb = N == SEQ ? WSP(bf16_t, WS_HF) + (size_t)layer * 2 * 256 * 4096 : WSP(bf16_t, WS_HFC) + (size_t)layer * 2 * 256 * 512;
    const int lane = F.lane, w = F.wid;
    for (int id = F.tid; id < 16 * N / 8; id += 512) { const int b = id / (N / 8), t8 = id % (N / 8);
        *(LAS u32x4*)(ZT + b * ZS + t8 * 16) = *(const u32x4*)(UTb + ((size_t)(2 * 256 + c) * 16 + b) * N + t8 * 8); }
    const int r16 = lane & 15, g = lane >> 4, m = r16 & 7, rq = r16 & 8;
    LAS unsigned char* baseA = CP + m * CPS + 2 * (N + 8 * g - rq - 16 * TPW * w);
    LAS unsigned char* baseB = ZT + r16 * ZS + 16 * g;
#pragma unroll 1
    for (int ord = 0; ord < 2; ++ord) {
        const bf16_t* G = HFb + ((size_t)ord * 256 + c) * (2 * N);
        LAS bf16_t* GS = (LAS bf16_t*)(ZT + 16 * ZS);
        for (int ch = F.tid; ch < 2 * N / 8; ch += 512) { const u32x4 v = *(const u32x4*)(G + 8 * ch);
            if (8 * ch >= N) { if (ch == N / 8) { u32x4 w = v; w.x &= 0xffff0000u; (void)w; } *(LAS u32x4*)(GS + 8 * ch) = v; }
            else { const int x0 = N - 8 * ch;
                GS[x0] = (bf16_t)(v.x & 0xffff); GS[x0 - 1] = (bf16_t)(v.x >> 16); GS[x0 - 2] = (bf16_t)(v.y & 0xffff); GS[x0 - 3] = (bf16_t)(v.y >> 16);
                GS[x0 - 4] = (bf16_t)(v.z & 0xffff); GS[x0 - 5] = (bf16_t)(v.z >> 16); GS[x0 - 6] = (bf16_t)(v.w & 0xffff); GS[x0 - 7] = (bf16_t)(v.w >> 16); } }
        __syncthreads();
        if (F.tid == 0) GS[0] = (bf16_t)0;
        if (F.tid == 1) GS[N] = G[0];
        __syncthreads();
        for (int id = F.tid; id < 2 * N; id += 512) { const int mm = id / (2 * N / 8), ch = id % (2 * N / 8); bf16_t v[8];
#pragma unroll
            for (int j = 0; j < 8; ++j) { const int x = 8 * ch + j - mm; v[j] = x >= 0 ? GS[x] : (bf16_t)0; }
            u32x4 wv; wv.x = v[0] | ((unsigned)v[1] << 16); wv.y = v[2] | ((unsigned)v[3] << 16); wv.z = v[4] | ((unsigned)v[5] << 16); wv.w = v[6] | ((unsigned)v[7] << 16);
            *(LAS u32x4*)(CP + mm * CPS + ch * 16) = wv; }
        __syncthreads();
        f32x4 acc[TPW]; bf16x8 win[TPW];
#pragma unroll
        for (int a = 0; a < TPW; ++a) acc[a] = (f32x4){0.f, 0.f, 0.f, 0.f};
#pragma unroll
        for (int a = 2; a < TPW; ++a) win[a] = *(const LAS bf16x8*)(baseA - 32 * a);
#pragma unroll 1
        for (int s8 = 0; s8 < NSIG / 8; ++s8) {
#pragma unroll
            for (int e = 0; e < 8; ++e) {
                const int sg = s8 * 8 + e;
                win[(0 - 2 * e) & (TPW - 1)] = *(const LAS bf16x8*)(baseA + 64 * sg);
                win[(1 - 2 * e) & (TPW - 1)] = *(const LAS bf16x8*)(baseA + 64 * sg - 32);
                const bf16x8 bfr = *(const LAS bf16x8*)(baseB + 64 * sg);
#pragma unroll
                for (int a = 0; a < TPW; ++a) acc[a] = __builtin_amdgcn_mfma_f32_16x16x32_bf16(win[(a - 2 * e) & (TPW - 1)], bfr, acc[a], 0, 0, 0);
            }
        }
        __syncthreads();
        const float bias = hy_bias[((size_t)layer * 2 + ord) * 256 + c];
        const bf16_t* gatep = UTb + ((size_t)(ord * 256 + c) * 16 + r16) * N;
#pragma unroll
        for (int a = 0; a < TPW; ++a) {
            const int t = 16 * (TPW * w + a) + 4 * g;
            const u32x2 gv = *(const u32x2*)(gatep + t); const u32x2 zv = *(const LAS u32x2*)(ZT + r16 * ZS + t * 2);
            const float y0 = bflo(gv.x) * (acc[a][0] + bias * bflo(zv.x)), y1 = bfhi(gv.x) * (acc[a][1] + bias * bfhi(zv.x));
            const float y2 = bflo(gv.y) * (acc[a][2] + bias * bflo(zv.y)), y3 = bfhi(gv.y) * (acc[a][3] + bias * bfhi(zv.y));
            u32x2 o; o.x = cvt_pk_bf16(y0, y1); o.y = cvt_pk_bf16(y2, y3);
            if (ord == 0) *(LAS u32x2*)(ZT + r16 * ZS + t * 2) = o;
            else __hip_atomic_store((unsigned long long*)(OUT + ((size_t)c * 16 + r16) * N + t), (unsigned long long)o.x | ((unsigned long long)o.y << 32), __ATOMIC_RELAXED, __HIP_MEMORY_SCOPE_AGENT);
        }
        __syncthreads();
    }
    asm volatile("s_waitcnt vmcnt(0)" ::: "memory");
    __syncthreads();
    if (F.tid == 0) __hip_atomic_fetch_add(F.ctl + CW_QUEUE + layer * 256 + (N == SEQ ? 64 : 128), 1u, __ATOMIC_RELAXED, __HIP_MEMORY_SCOPE_AGENT);
}

__device__ __forceinline__ int take_ticket(const Frame& F, volatile LAS int* tk, unsigned* q) {
    if (F.tid == 0) *tk = (int)__hip_atomic_fetch_add(q, 1u, __ATOMIC_RELAXED, __HIP_MEMORY_SCOPE_AGENT);
    __syncthreads(); const int u = *tk; __syncthreads(); return u;
}
__device__ __forceinline__ int take_xcd_ticket(const Frame& F, volatile LAS int* tk, unsigned* qbase, int nper) {
    if (F.tid == 0) { const int x0 = (int)xb_xcc_id() & 7; int res = -1;
        for (int i = 0; i < 8; ++i) { const int x = (x0 + i) & 7; const int t = (int)__hip_atomic_fetch_add(qbase + x * 16, 1u, __ATOMIC_RELAXED, __HIP_MEMORY_SCOPE_AGENT); if (t < nper) { res = x * nper + t; break; } }
        *tk = res; }
    __syncthreads(); const int u = *tk; __syncthreads(); return u;
}
__device__ __forceinline__ void ph_mix(LAS unsigned char* lds, int layer, bool need_ctx) {
#define TAKEX(kind, nper) ({ const Frame Ft = make_frame(); take_xcd_ticket(Ft, (volatile LAS int*)(lds + LDS_MISC + 64), Ft.ctl + CW_XQ + (layer * 2 + (kind)) * 128, (nper)); })
#define TAKE(qoff) ({ const Frame Ft = make_frame(); take_ticket(Ft, (volatile LAS int*)(lds + LDS_MISC + 64), Ft.ctl + CW_QUEUE + layer * 256 + (qoff)); })
#pragma unroll 1
    for (;;) { const int u = TAKE(0); if (u >= 256) break; const Frame F = make_frame(); hyena_unit<SEQ>(F, lds, layer, u); }
    const int pda = 64 + (need_ctx ? 8 : 0);
#pragma unroll 1
    for (;;) { const int u = TAKEX(0, pda); if (u < 0) break; const Frame F = make_frame(); const int x = u / pda, t = u % pda;
        int b, h, q0, nk; if (t < 64) { const int g = x * 8 + (t >> 3); b = g >> 2; h = g & 3; q0 = CTXL + (t & 7) * 256; nk = TPB; } else { const int i = x * 8 + (t - 64); b = i >> 2; h = i & 3; q0 = 0; nk = CTXL; }
        attn_unit<0>(F, lds, layer, b, h, q0, nk); }
    const int pml = 96 + (need_ctx ? 12 : 0);
#pragma unroll 1
    for (;;) { const int u = TAKEX(1, pml); if (u < 0) break; const Frame F = make_frame(); const int x = u / pml, t = u % pml;
        int b, h, q0, nk; if (t < 96) { const int g = x * 12 + (t >> 3); b = g / 6; h = g % 6; q0 = CTXL + (t & 7) * 256; nk = TPB; } else { const int i = x * 12 + (t - 96); b = i / 6; h = i % 6; q0 = 0; nk = CTXL; }
        attn_unit<1>(F, lds, layer, b, h, q0, nk); }
    if (need_ctx) {
#pragma unroll 1
        for (;;) { const int u = TAKE(192); if (u >= 256) break; const Frame F = make_frame(); hyena_unit<CTXL>(F, lds, layer, u); }
    }
    { const Frame F = make_frame(); wait_count(F, F.ctl + CW_QUEUE + layer * 256 + 64, 256u); }
#pragma unroll 1
    for (;;) { const int u = TAKE(96); if (u >= 256) break;
#pragma unroll 1
        for (int k = 0; k < 2; ++k) { const Frame F = make_frame(); hyt_unit(F, lds, false, 2 * u + k); } }
    if (layer & 1) {
        const int mi = layer >> 1; constexpr int TGU = 5632 / 32, ND = NE * 16;
#pragma unroll 1
        for (;;) { const int u = TAKE(224); if (u >= ND + NE * TGU) break; const Frame F = make_frame(); LAS float* tile = (LAS float*)lds;
            if (u < ND) { const int e = u >> 4, r2 = u & 15; const size_t so = ((size_t)mi * NE + e) * 1024 * FF;
                convert_unit_i8<3, 1, FF>(F, tile, F.in[38] + so, nullptr, 1024, WSP(signed char, WS_MD) + (size_t)e * 1024 * FF, WSP(float, WS_MDS) + e * 1024, r2 * 64); }
            else { const int v = u - ND, e = v / TGU, r = v % TGU; const size_t so = ((size_t)mi * NE + e) * 1024 * FF;
                convert_unit_gu32(F, tile, F.in[36] + so, F.in[37] + so, WSP(signed char, WS_MGU) + (size_t)e * 5632 * 1024, WSP(float, WS_MGUS) + e * 5632, r * 32); } }
    }
    if (need_ctx) {
        { const Frame F = make_frame(); wait_count(F, F.ctl + CW_QUEUE + layer * 256 + 128, 256u); }
#pragma unroll 1
        for (;;) { const int u = TAKE(160); if (u >= 64) break; const Frame F = make_frame(); hyt_unit(F, lds, true, u); }
    }
#undef TAKE
#undef TAKEX
}

constexpr int NPH = 2 + 15 * DEPTH;
__host__ __device__ inline bool phase_active(int gp) { if (gp < 2) return true; const int l = (gp - 2) / 15, p = (gp - 2) % 15; return (l & 1) ? (p <= 7 + 2 * MOE_NCH || p == 14) : (p <= 8 || p == 14); }

template <int layer>
__device__ __forceinline__ void layer_phases(LAS unsigned char* lds, const int lo, const int hi) {
#define IN(k) (lo <= (k) && (k) < hi)
#define SEAM(k) do { if ((k) + 1 < hi) xcd_barrier_impl((unsigned*)(kargs()->ws + WS_CTL) + CW_BAR, xb_xcc_id(), (volatile LAS unsigned*)(lds + LDS_MISC)); } while (0)
        const int base = 2 + 15 * layer;
        if (hi <= base || lo >= base + 15) return;
        constexpr bool moe = layer & 1, last = layer == DEPTH - 1, need_ctx = !last;
        constexpr int mi = layer >> 1;

        if (IN(base + 0)) { const Frame F = make_frame();
            pg8::Gemm g{WSP(bf16_t, WS_HMOD), (const bf16_t*)(WSP(signed char, WS_WIN) + (size_t)layer * NINP * 1024), 512};
            pg8::RowOrder S{MR / 256, NINP / 256, F.G, F.bid, 0};
            EpiProj E{WSP(bf16_t, WS_PROJ), WSP(float, WS_ROPE_DA), WSP(float, WS_ROPE_ML), WSP(float, WS_HSC), WSP(float, WS_WINS) + layer * NINP, WSP(float, WS_SS)};
            pg8::gemm_phase<EpiProj, pg8::RowOrder, 1>(lds, g, S, E);
            SEAM(base + 0);
        }
        if (IN(base + 2)) { const Frame F = make_frame();
            { pg8::Gemm g{WSP(bf16_t, WS_PROJ) + C_CQ, WSP(bf16_t, WS_WUQ) + (size_t)layer * 768 * 256, 256, PLD, 0};
              pg8::RowOrder S{MR / 256, 3, F.G, F.bid, 0};
              EpiMlaQ E{WSP(bf16_t, WS_MQ), WSP(float, WS_ROPE_ML), WSP(float, WS_SS)};
              pg8::gemm_phase(lds, g, S, E); }
            __syncthreads();
            { pg8::Gemm g{WSP(bf16_t, WS_PROJ) + C_CKV, WSP(bf16_t, WS_WUKV) + (size_t)layer * 768 * 256, 128, PLD, 256};
              pg8::RowOrder S{MR / 256, 3, F.G, F.bid, 0};
              EpiMlaKV E{WSP(bf16_t, WS_MKV), WSP(float, WS_SS)};
              pg8::gemm_phase(lds, g, S, E); }
            __syncthreads();
            ph_conv(lds, layer, need_ctx);
            SEAM(base + 2);
        }
        if (IN(base + 3)) { const Frame F = make_frame(); ph_mix(lds, layer, need_ctx); SEAM(base + 3); }
        if (IN(base + 5)) { const Frame F = make_frame();
            pg8::Gemm g{WSP(bf16_t, WS_MIX), WSP(bf16_t, WS_WOUT) + (size_t)layer * 1024 * 1024, 1024};
            pg8::RowOrder S{last ? 128 : MR / 256, 4, F.G, F.bid, last ? 1 : 0};
            EpiResid<layer == 0> E{WSP(bf16_t, WS_YH), WSP(bf16_t, WS_XH), WSP(float, WS_MOD) + (size_t)layer * 17 * 6144 + 2 * 1024, nullptr, 1.f};
            pg8::gemm_phase(lds, g, S, E);
            SEAM(base + 5);
        }
        if (IN(base + 6)) { const Frame F = make_frame(); ph_ln1(F, lds, layer, last); SEAM(base + 6); }
        if (!moe) {
            if (IN(base + 7)) { const Frame F = make_frame();
                pg8::Gemm g{WSP(bf16_t, WS_HMOD), (const bf16_t*)(WSP(signed char, WS_WGU) + (size_t)mi * 5632 * 1024), 512};
                pg8::RowOrder S{MR / 256, 22, F.G, F.bid, 0};
                EpiSwiglu E{WSP(unsigned char, WS_HID), WSP(float, WS_HSC), WSP(float, WS_WGUS) + mi * 5632};
                pg8::gemm_phase<EpiSwiglu, pg8::RowOrder, 1>(lds, g, S, E);
                SEAM(base + 7);
            }
            if (IN(base + 8)) { const Frame F = make_frame();
                pg8::Gemm g{WSP(bf16_t, WS_HID), (const bf16_t*)(WSP(signed char, WS_WD) + (size_t)mi * 1024 * FF), FF / 2};
                pg8::RowOrder S{MR / 256, 4, F.G, F.bid, 0};
                EpiResid<false> E{WSP(bf16_t, WS_YH), WSP(bf16_t, WS_XH), WSP(float, WS_MOD) + (size_t)layer * 17 * 6144 + 5 * 1024, WSP(float, WS_WDS) + mi * 1024, 1.0f / HSCL};
                pg8::gemm_phase<EpiResid<false>, pg8::RowOrder, 2>(lds, g, S, E);
                SEAM(base + 8);
            }
        } else {
            if (IN(base + 7)) { const Frame F = make_frame(); ph_gather(F, lds, layer, last); SEAM(base + 7); }
#pragma unroll 1
            for (int ch = 0; ch < MOE_NCH; ++ch) {
                if (IN(base + 8 + 2 * ch)) { const Frame F = make_frame(); const unsigned* mt = F.ctl + CW_MTILE + mi * 512;
                    const int NT = (int)mt[0]; int nM = NT - ch * MOE_CH; nM = nM > MOE_CH ? MOE_CH : nM;
                    pg8::Gemm g{WSP(bf16_t, WS_ROWS8), WSP(bf16_t, WS_MGU), 512};
                    LAS unsigned* lmt = (LAS unsigned*)(lds + pg8::STAGE_BYTES + 4096);
                    for (int i = F.tid; i < NT; i += 512) lmt[i] = mt[1 + i];
                    __syncthreads();
                    pg8::MoeOrder S{nM, 22, F.G, F.bid, ch * MOE_CH, 0, 1, lmt, (size_t)5632 * 1024};
                    EpiSwiglu E{WSP(unsigned char, WS_HIDC), WSP(float, WS_RSC), WSP(float, WS_MGUS)};
                    pg8::gemm_phase<EpiSwiglu, pg8::MoeOrder, 1>(lds, g, S, E);
                    SEAM(base + 8 + 2 * ch);
                }
                if (IN(base + 9 + 2 * ch)) { const Frame F = make_frame(); const unsigned* mt = F.ctl + CW_MTILE + mi * 512;
                    const int NT = (int)mt[0]; int nM = NT - ch * MOE_CH; nM = nM > MOE_CH ? MOE_CH : nM;
                    pg8::Gemm g{WSP(bf16_t, WS_HIDC), WSP(bf16_t, WS_MD), FF / 2};
                    LAS unsigned* lmt = (LAS unsigned*)(lds + pg8::STAGE_BYTES + 4096);
                    for (int i = F.tid; i < NT; i += 512) lmt[i] = mt[1 + i];
                    __syncthreads();
                    pg8::MoeOrder S{nM, 4, F.G, F.bid, ch * MOE_CH, 1, 0, lmt, (size_t)1024 * FF};
                    EpiBf16 E{WSP(bf16_t, WS_ROWS), 1024, WSP(float, WS_MDS), 1.0f / HSCL};
                    pg8::gemm_phase<EpiBf16, pg8::MoeOrder, 2>(lds, g, S, E);
                    SEAM(base + 9 + 2 * ch);
                }
            }
        }
        if (IN(base + 14)) { const Frame F = make_frame(); ph_ln2(F, layer, last); SEAM(base + 14); }
    #undef IN
#undef SEAM
}

__global__ void __launch_bounds__(512, 2) fwd(Args args) {
    extern __shared__ __attribute__((aligned(16))) unsigned char lds_raw[];
    LAS unsigned char* lds = (LAS unsigned char*)lds_raw;
    if (threadIdx.x < 64) ((LAS unsigned*)(lds + LDS_MISC))[threadIdx.x] = 0u;
    __syncthreads();
    XcdBarrier bar; bar.bar = (unsigned*)(args.ws + WS_CTL) + CW_BAR; bar.x = 0; bar.st = (volatile LAS unsigned*)(lds + LDS_MISC);
    if (args.use_bar) bar = xcd_barrier_post((unsigned*)(args.ws + WS_CTL) + CW_BAR, (volatile LAS unsigned*)(lds + LDS_MISC));
    const int lo = args.ph_lo, hi = args.ph_hi; (void)bar;
#define IN(k) (lo <= (k) && (k) < hi)
#define SEAM(k) do { if ((k) + 1 < hi) xcd_barrier_impl((unsigned*)(kargs()->ws + WS_CTL) + CW_BAR, xb_xcc_id(), (volatile LAS unsigned*)(lds + LDS_MISC)); } while (0)

    if (IN(0)) { const Frame F = make_frame();
        ph_mods(F, lds); __syncthreads();
        ph_tables(F);
        ph_filters(F, lds); __syncthreads();
        LAS float* tile = (LAS float*)lds;
        for (int l = 0; l < DEPTH; ++l) {
            { int u0 = F.bid - 37 * (l + 1) % 256; if (u0 < 0) u0 += F.G; for (int u = u0; u < NINP / 64; u += F.G) convert_unit_i8<0>(F, tile, F.in[6] + (size_t)l * 1024 * PLD, nullptr, PLD, WSP(signed char, WS_WIN) + (size_t)l * NINP * 1024, WSP(float, WS_WINS) + l * NINP, u * 64); }
            convert_matrix<3>(F, tile, F.in[27] + (size_t)l * 1024 * 1024, nullptr, 1024, 1024, WSP(bf16_t, WS_WOUT) + (size_t)l * 1024 * 1024, 1024, 1024, nullptr, 74);
            convert_matrix<1>(F, tile, F.in[24] + (size_t)l * 256 * MQLD, nullptr, MQLD, 256, WSP(bf16_t, WS_WUQ) + (size_t)l * 768 * 256, 256, 768, F.in[23] + l * 256, 111);
            convert_matrix<3>(F, tile, F.in[26] + (size_t)l * 128 * 768, nullptr, 768, 128, WSP(bf16_t, WS_WUKV) + (size_t)l * 768 * 256, 256, 768, F.in[25] + l * 128, 148);
        }
        for (int i = 0; i < 2; ++i) {
            { int u0 = F.bid - (101 + 90 * i); if (u0 < 0) u0 += F.G; for (int u = u0; u < 5632 / 32; u += F.G) convert_unit_gu32(F, tile, F.in[32] + (size_t)i * 1024 * FF, F.in[33] + (size_t)i * 1024 * FF, WSP(signed char, WS_WGU) + (size_t)i * 5632 * 1024, WSP(float, WS_WGUS) + i * 5632, u * 32); }
            { int u0 = F.bid - (60 + 30 * i); if (u0 < 0) u0 += F.G; for (int u = u0; u < 16; u += F.G) convert_unit_i8<3, 1, FF>(F, tile, F.in[34] + (size_t)i * FF * 1024, nullptr, 1024, WSP(signed char, WS_WD) + (size_t)i * 1024 * FF, WSP(float, WS_WDS) + i * 1024, u * 64); }
        }
        SEAM(0);
    }
    if (IN(1)) { const Frame F = make_frame(); ph_init(F); SEAM(1); }

    layer_phases<0>(lds, lo, hi);
    layer_phases<1>(lds, lo, hi);
    layer_phases<2>(lds, lo, hi);
    layer_phases<3>(lds, lo, hi);
#undef IN
#undef SEAM
}

extern "C" void kernel_launch(void* const* d_in, const int* in_sizes, int n_in, void* d_out, int out_size, void* d_ws, size_t ws_size, hipStream_t stream) {
    static int grid = 0;
    if (grid == 0) {
        if (n_in != 39 || ws_size < WS_END) { fprintf(stderr, "kernel_launch: need 39 inputs and %zu workspace bytes (got %d, %zu)\n", (size_t)WS_END, n_in, ws_size); grid = -1; return; }
        int dev = 0, cus = 0, per_cu = 0;
        if (hipGetDevice(&dev) != hipSuccess || hipDeviceGetAttribute(&cus, hipDeviceAttributeMultiprocessorCount, dev) != hipSuccess) { grid = -1; return; }
        if (hipFuncSetAttribute((const void*)fwd, hipFuncAttributeMaxDynamicSharedMemorySize, LDS_BYTES) != hipSuccess) { fprintf(stderr, "kernel_launch: hipFuncSetAttribute failed\n"); grid = -1; return; }
        if (hipOccupancyMaxActiveBlocksPerMultiprocessor(&per_cu, (const void*)fwd, 512, LDS_BYTES) != hipSuccess || per_cu < 1) { fprintf(stderr, "kernel_launch: occupancy query reports %d\n", per_cu); (void)hipGetLastError(); }
        grid = cus;
    }
    if (grid < 0) return;
    (void)hipMemsetAsync((char*)d_ws + WS_CTL, 0, CTL_BYTES, stream);
    Args a{};
    for (int i = 0; i < 39; ++i) a.in[i] = (const float*)d_in[i];
    a.out = (float*)d_out; a.ws = (unsigned char*)d_ws; a.pad = 0;
#if MK_SINGLE
    a.ph_lo = 0; a.ph_hi = NPH; a.use_bar = 1;
    hipLaunchKernelGGL(fwd, dim3(grid), dim3(512), LDS_BYTES, stream, a);
#else
    for (int gp = 0; gp < NPH; ++gp) { if (!phase_active(gp)) continue; a.ph_lo = gp; a.ph_hi = gp + 1; a.use_bar = 0;
        hipLaunchKernelGGL(fwd, dim3(grid), dim3(512), LDS_BYTES, stream, a); }
#endif
}
```
